# Optimizing an MI355X kernel written in HIP

```python
import math
import jax, jax.numpy as jnp
from jax import lax
import numpy as np

D_MODEL = 1024
BATCH = 16
SEQ = 256
DEPTH = 1
DEC_BATCH = 4
DEC_SEQ = 4096
PAST_LEN = 512

GRID_W = 64
HEAD_DIM = 64
N_HEADS = 8
KV_HEADS = 2
REP = N_HEADS // KV_HEADS
ATTN_WIDTH = N_HEADS * HEAD_DIM
KV_WIDTH = KV_HEADS * HEAD_DIM
WINDOW = 128
BLOCK = 128
ROPE_THETA = 10000.0
ROPE_FREQS = HEAD_DIM // 4
SSM_CH = 16
SSM_WIDTH = D_MODEL - ATTN_WIDTH
SSM_GROUPS = SSM_WIDTH // SSM_CH
SSM_STATE = 64
N_DIRS = 2
IN_WIDTH = ATTN_WIDTH + 2 * KV_WIDTH + SSM_WIDTH
D_FF = 2816
CONV_W = 3
EPS = 1e-6
NEG_INF = -1e30

kernel_name = "hymba_s5_prefix_dit_step"


def rms_norm(x, g):
    xf = x.astype(jnp.float32)
    y = xf * lax.rsqrt(jnp.mean(xf * xf, axis=-1, keepdims=True) + EPS)
    return (y * g.astype(jnp.float32)).astype(x.dtype)


def adaln(cond, w_ada, b_ada):
    mod = jax.nn.silu(cond) @ w_ada + b_ada
    return jnp.split(mod, 6, axis=-1)


def modulate(x, g, shift, scale):
    return rms_norm(x, g) * (1 + scale[:, None, :]) + shift[:, None, :]


def in_projection(h, w_in):
    b, n = h.shape[:2]
    proj = h @ w_in
    q, k, v, u = jnp.split(proj, [ATTN_WIDTH, ATTN_WIDTH + KV_WIDTH, ATTN_WIDTH + 2 * KV_WIDTH], axis=-1)
    return (q.reshape(b, n, N_HEADS, HEAD_DIM), k.reshape(b, n, KV_HEADS, HEAD_DIM),
            v.reshape(b, n, KV_HEADS, HEAD_DIM), u)


def axial_rope_angles(n_tokens):
    rows = n_tokens // GRID_W
    row = jnp.repeat(jnp.arange(rows, dtype=jnp.float32), GRID_W)
    col = jnp.tile(jnp.arange(GRID_W, dtype=jnp.float32), rows)
    inv_freq = ROPE_THETA ** (-jnp.arange(ROPE_FREQS, dtype=jnp.float32) / ROPE_FREQS)
    return row[:, None] * inv_freq[None, :], col[:, None] * inv_freq[None, :]


def _rotate_half(v, ang):
    v1, v2 = jnp.split(v, 2, axis=-1)
    cos = jnp.cos(ang)[None, :, None, :]
    sin = jnp.sin(ang)[None, :, None, :]
    return jnp.concatenate([v1 * cos - v2 * sin, v1 * sin + v2 * cos], axis=-1)


def apply_axial_rope(x, ang_row, ang_col):
    xf = x.astype(jnp.float32)
    half = HEAD_DIM // 2
    out = jnp.concatenate([_rotate_half(xf[..., :half], ang_row),
                           _rotate_half(xf[..., half:], ang_col)], axis=-1)
    return out.astype(x.dtype)


def _sink_column(sink, b):
    s = sink.astype(jnp.float32).reshape(1, KV_HEADS, REP, 1, 1)
    return jnp.broadcast_to(s, (b, KV_HEADS, REP, BLOCK, 1))


def context_attention(q, k, v, sink):
    b, lc = q.shape[:2]
    nq = lc // BLOCK
    scale = HEAD_DIM ** -0.5
    qb = q.reshape(b, nq, BLOCK, KV_HEADS, REP, HEAD_DIM).transpose(1, 0, 2, 3, 4, 5)
    sink_col = _sink_column(sink, b)

    def one_block(qi):
        s = jnp.einsum("bqkrd,bskd->bkrqs", qi, k).astype(jnp.float32) * scale
        p = jax.nn.softmax(jnp.concatenate([s, sink_col], axis=-1), axis=-1)[..., :-1]
        return jnp.einsum("bkrqs,bskd->bqkrd", p.astype(v.dtype), v)

    o = lax.map(one_block, qb)
    return o.transpose(1, 0, 2, 3, 4, 5).reshape(b, lc, ATTN_WIDTH)


def latent_attention(q, k, v, ck, cv, sink):
    b, n = q.shape[:2]
    nb = n // BLOCK
    scale = HEAD_DIM ** -0.5
    qb = q.reshape(b, nb, BLOCK, KV_HEADS, REP, HEAD_DIM).transpose(1, 0, 2, 3, 4, 5)

    def windows(t):
        tp = jnp.pad(t, ((0, 0), (BLOCK, BLOCK), (0, 0), (0, 0))).reshape(b, nb + 2, BLOCK, KV_HEADS, HEAD_DIM)
        w = jnp.concatenate([tp[:, :-2], tp[:, 1:-1], tp[:, 2:]], axis=2)
        return w.transpose(1, 0, 2, 3, 4)

    kw, vw = windows(k), windows(v)
    r_idx = jnp.arange(BLOCK)[:, None]
    w_idx = jnp.arange(3 * BLOCK)[None, :]
    band = (w_idx >= r_idx + BLOCK - WINDOW) & (w_idx <= r_idx + BLOCK + WINDOW)
    sink_col = _sink_column(sink, b)

    def one_block(args):
        qi, ki, vi, blk = args
        j = (blk - 1) * BLOCK + w_idx
        valid = band & (j >= 0) & (j < n)
        s_loc = jnp.einsum("bqkrd,bskd->bkrqs", qi, ki).astype(jnp.float32) * scale
        s_loc = jnp.where(valid[None, None, None], s_loc, NEG_INF)
        s_ctx = jnp.einsum("bqkrd,bskd->bkrqs", qi, ck).astype(jnp.float32) * scale
        p = jax.nn.softmax(jnp.concatenate([s_loc, s_ctx, sink_col], axis=-1), axis=-1)
        p_loc = p[..., :3 * BLOCK].astype(vi.dtype)
        p_ctx = p[..., 3 * BLOCK:-1].astype(cv.dtype)
        return (jnp.einsum("bkrqs,bskd->bqkrd", p_loc, vi)
                + jnp.einsum("bkrqs,bskd->bqkrd", p_ctx, cv))

    o = lax.map(one_block, (qb, kw, vw, jnp.arange(nb)))
    return o.transpose(1, 0, 2, 3, 4, 5).reshape(b, n, ATTN_WIDTH)


def zoh_discretize(lam_re, lam_im, log_dt, b_re, b_im):
    lam_re = lam_re.astype(jnp.float32)
    lam_im = lam_im.astype(jnp.float32)
    dt = jnp.exp(log_dt.astype(jnp.float32))[:, None]
    mag = jnp.exp(lam_re * dt)
    ang = lam_im * dt
    a_re, a_im = mag * jnp.cos(ang), mag * jnp.sin(ang)
    den = lam_re * lam_re + lam_im * lam_im
    num_re = a_re - 1.0
    coef_re = (num_re * lam_re + a_im * lam_im) / den
    coef_im = (a_im * lam_re - num_re * lam_im) / den
    br, bi = b_re.astype(jnp.float32), b_im.astype(jnp.float32)
    bb_re = coef_re[..., None] * br - coef_im[..., None] * bi
    bb_im = coef_re[..., None] * bi + coef_im[..., None] * br
    return a_re, a_im, bb_re, bb_im


def _combine(e1, e2):
    a1r, a1i, b1r, b1i = e1
    a2r, a2i, b2r, b2i = e2
    return (a2r * a1r - a2i * a1i, a2r * a1i + a2i * a1r,
            a2r * b1r - a2i * b1i + b2r, a2r * b1i + a2i * b1r + b2i)


def diagonal_scan(u, a_re, a_im, bb_re, bb_im, h0, reverse):
    bu_re = jnp.einsum("bngp,gsp->bngs", u, bb_re)
    bu_im = jnp.einsum("bngp,gsp->bngs", u, bb_im)
    if h0 is not None:
        h0_re, h0_im = h0
        edge = -1 if reverse else 0
        bu_re = bu_re.at[:, edge].add(a_re * h0_re - a_im * h0_im)
        bu_im = bu_im.at[:, edge].add(a_re * h0_im + a_im * h0_re)
    ar = jnp.broadcast_to(a_re, bu_re.shape)
    ai = jnp.broadcast_to(a_im, bu_im.shape)
    _, _, h_re, h_im = lax.associative_scan(_combine, (ar, ai, bu_re, bu_im), reverse=reverse, axis=1)
    return h_re, h_im


def s5_bidirectional(u, params, h0_re, h0_im, return_final):
    lam_re, lam_im, log_dt, b_re, b_im, c_re, c_im, d, w_glu = params
    b, n = u.shape[:2]
    uf = u.astype(jnp.float32).reshape(b, n, SSM_GROUPS, SSM_CH)
    y = uf * d.astype(jnp.float32)
    fin_re, fin_im = [], []
    for dr, reverse in enumerate((False, True)):
        a_re, a_im, bb_re, bb_im = zoh_discretize(lam_re[dr], lam_im[dr], log_dt[dr], b_re[dr], b_im[dr])
        h0 = None if h0_re is None else (h0_re[:, dr].astype(jnp.float32), h0_im[:, dr].astype(jnp.float32))
        h_re, h_im = diagonal_scan(uf, a_re, a_im, bb_re, bb_im, h0, reverse)
        y = (y + jnp.einsum("bngs,gps->bngp", h_re, c_re[dr].astype(jnp.float32))
             - jnp.einsum("bngs,gps->bngp", h_im, c_im[dr].astype(jnp.float32)))
        if return_final:
            edge = 0 if reverse else -1
            fin_re.append(h_re[:, edge])
            fin_im.append(h_im[:, edge])
    x = jax.nn.gelu(y)
    out = x * jax.nn.sigmoid(jnp.einsum("bngp,gpq->bngq", x, w_glu.astype(jnp.float32)))
    out = out.reshape(b, n, SSM_WIDTH).astype(u.dtype)
    if return_final:
        return out, jnp.stack(fin_re, axis=1).astype(u.dtype), jnp.stack(fin_im, axis=1).astype(u.dtype)
    return out


def merge_groups(attn, ssm, g_attn, g_ssm, w_out):
    return jnp.concatenate([rms_norm(attn, g_attn), rms_norm(ssm, g_ssm)], axis=-1) @ w_out


def conv_ffn(h, w_up, conv_w, conv_b, w_down):
    n = h.shape[1]
    pad = CONV_W // 2
    up = jnp.pad(h @ w_up, ((0, 0), (pad, pad), (0, 0)))
    acc = up[:, 0:n] * conv_w[0]
    for i in range(1, CONV_W):
        acc = acc + up[:, i:i + n] * conv_w[i]
    g, val = jnp.split(acc + conv_b, 2, axis=-1)
    return (jax.nn.silu(g) * val) @ w_down


def setup_inputs(seed: int = 0) -> dict:
    key = jax.random.key(seed)
    ks = jax.random.split(key, 40)
    f32 = jnp.float32

    def nrm(k, shape, s):
        return jax.random.normal(k, shape, f32) * s

    n_idx = jnp.arange(SSM_STATE, dtype=f32)
    ssm_shape = (DEPTH, N_DIRS, SSM_GROUPS, SSM_STATE)
    return {
        "x_prompt": nrm(ks[0], (BATCH, SEQ, D_MODEL), 1.0),
        "x_sample": nrm(ks[1], (DEC_BATCH, DEC_SEQ, D_MODEL), 1.0),
        "cache_k": nrm(ks[2], (DEC_BATCH, DEPTH, PAST_LEN, KV_HEADS, HEAD_DIM), 1.0),
        "cache_v": nrm(ks[3], (DEC_BATCH, DEPTH, PAST_LEN, KV_HEADS, HEAD_DIM), 1.0),
        "state_ssm_re": nrm(ks[4], (DEC_BATCH, DEPTH, N_DIRS, SSM_GROUPS, SSM_STATE), 0.5),
        "state_ssm_im": nrm(ks[5], (DEC_BATCH, DEPTH, N_DIRS, SSM_GROUPS, SSM_STATE), 0.5),
        "c": nrm(ks[6], (DEC_BATCH, D_MODEL), 1.0),
        "c_ctx": nrm(ks[7], (D_MODEL,), 1.0),
        "w_ada": nrm(ks[8], (DEPTH, D_MODEL, 6 * D_MODEL), 0.5 * D_MODEL ** -0.5),
        "b_ada": nrm(ks[9], (DEPTH, 6 * D_MODEL), 0.01),
        "g_norm1": 1.0 + nrm(ks[10], (DEPTH, D_MODEL), 0.02),
        "g_norm2": 1.0 + nrm(ks[11], (DEPTH, D_MODEL), 0.02),
        "w_in": nrm(ks[12], (DEPTH, D_MODEL, IN_WIDTH), D_MODEL ** -0.5),
        "attn_sink": nrm(ks[13], (DEPTH, N_HEADS), 0.5),
        "ssm_lam_re": -0.5 + nrm(ks[14], ssm_shape, 0.01),
        "ssm_lam_im": math.pi * n_idx + nrm(ks[15], ssm_shape, 0.01),
        "ssm_log_dt": jax.random.uniform(ks[16], (DEPTH, N_DIRS, SSM_GROUPS), f32, math.log(1e-3), math.log(1e-1)),
        "ssm_b_re": nrm(ks[17], (DEPTH, N_DIRS, SSM_GROUPS, SSM_STATE, SSM_CH), (2 * SSM_CH) ** -0.5),
        "ssm_b_im": nrm(ks[18], (DEPTH, N_DIRS, SSM_GROUPS, SSM_STATE, SSM_CH), (2 * SSM_CH) ** -0.5),
        "ssm_c_re": nrm(ks[19], (DEPTH, N_DIRS, SSM_GROUPS, SSM_CH, SSM_STATE), (2 * SSM_STATE) ** -0.5),
        "ssm_c_im": nrm(ks[20], (DEPTH, N_DIRS, SSM_GROUPS, SSM_CH, SSM_STATE), (2 * SSM_STATE) ** -0.5),
        "ssm_d": nrm(ks[21], (DEPTH, SSM_GROUPS, SSM_CH), 1.0),
        "ssm_w_glu": nrm(ks[22], (DEPTH, SSM_GROUPS, SSM_CH, SSM_CH), SSM_CH ** -0.5),
        "g_out_attn": 1.0 + nrm(ks[23], (DEPTH, ATTN_WIDTH), 0.02),
        "g_out_ssm": 1.0 + nrm(ks[24], (DEPTH, SSM_WIDTH), 0.02),
        "w_out": nrm(ks[25], (DEPTH, D_MODEL, D_MODEL), D_MODEL ** -0.5),
        "w_up": nrm(ks[26], (DEPTH, D_MODEL, 2 * D_FF), D_MODEL ** -0.5),
        "conv_w": nrm(ks[27], (DEPTH, CONV_W, 2 * D_FF), CONV_W ** -0.5),
        "conv_b": nrm(ks[28], (DEPTH, 2 * D_FF), 0.01),
        "w_down": nrm(ks[29], (DEPTH, D_FF, D_MODEL), D_FF ** -0.5),
        "g_final": 1.0 + nrm(ks[30], (D_MODEL,), 0.02),
    }


def reference(x_prompt, x_sample, cache_k, cache_v, state_ssm_re, state_ssm_im, c, c_ctx,
              w_ada, b_ada, g_norm1, g_norm2, w_in, attn_sink,
              ssm_lam_re, ssm_lam_im, ssm_log_dt, ssm_b_re, ssm_b_im, ssm_c_re, ssm_c_im,
              ssm_d, ssm_w_glu, g_out_attn, g_out_ssm, w_out, w_up, conv_w, conv_b, w_down, g_final):
    cond_ctx = jnp.broadcast_to(c_ctx[None, :], (x_prompt.shape[0], D_MODEL))
    ang_row, ang_col = axial_rope_angles(x_sample.shape[1])
    xp, xs = x_prompt, x_sample
    new_k, new_v, new_s_re, new_s_im = [], [], [], []
    for l in range(DEPTH):
        ssm_l = (ssm_lam_re[l], ssm_lam_im[l], ssm_log_dt[l], ssm_b_re[l], ssm_b_im[l],
                 ssm_c_re[l], ssm_c_im[l], ssm_d[l], ssm_w_glu[l])

        sh1, sc1, gt1, sh2, sc2, gt2 = adaln(cond_ctx, w_ada[l], b_ada[l])
        q, k, v, u = in_projection(modulate(xp, g_norm1[l], sh1, sc1), w_in[l])
        attn = context_attention(q, k, v, attn_sink[l])
        ssm, fin_re, fin_im = s5_bidirectional(u, ssm_l, None, None, True)
        xp = xp + gt1[:, None, :] * merge_groups(attn, ssm, g_out_attn[l], g_out_ssm[l], w_out[l])
        h = modulate(xp, g_norm2[l], sh2, sc2)
        xp = xp + gt2[:, None, :] * conv_ffn(h, w_up[l], conv_w[l], conv_b[l], w_down[l])
        new_k.append(k)
        new_v.append(v)
        new_s_re.append(fin_re)
        new_s_im.append(fin_im)

        sh1, sc1, gt1, sh2, sc2, gt2 = adaln(c, w_ada[l], b_ada[l])
        q, k, v, u = in_projection(modulate(xs, g_norm1[l], sh1, sc1), w_in[l])
        q = apply_axial_rope(q, ang_row, ang_col)
        k = apply_axial_rope(k, ang_row, ang_col)
        attn = latent_attention(q, k, v, cache_k[:, l], cache_v[:, l], attn_sink[l])
        ssm = s5_bidirectional(u, ssm_l, state_ssm_re[:, l], state_ssm_im[:, l], False)
        xs = xs + gt1[:, None, :] * merge_groups(attn, ssm, g_out_attn[l], g_out_ssm[l], w_out[l])
        h = modulate(xs, g_norm2[l], sh2, sc2)
        xs = xs + gt2[:, None, :] * conv_ffn(h, w_up[l], conv_w[l], conv_b[l], w_down[l])

    y_prompt = rms_norm(xp, g_final)
    y_sample = rms_norm(xs, g_final)
    return (y_prompt, y_sample, jnp.stack(new_k, axis=1), jnp.stack(new_v, axis=1),
            jnp.stack(new_s_re, axis=1), jnp.stack(new_s_im, axis=1))
```

```cpp
#include <hip/hip_runtime.h>
#include <cstdio>
#include <cstdint>
#include <cmath>

namespace ref {
constexpr int DM = 1024, NCTX = 4096, NLAT = 16384, NTOK = 20480, INW = 1280, DFF = 2816;
constexpr float EPS = 1e-6f;

__device__ __forceinline__ float siluf(float x) { return x / (1.f + __expf(-x)); }
__device__ __forceinline__ float wave_sum(float v) {
#pragma unroll
    for (int o = 1; o < 64; o <<= 1) v += __shfl_xor(v, o);
    return v;
}

__global__ void k_adaln(const float* __restrict__ c, const float* __restrict__ c_ctx, const float* __restrict__ w_ada, const float* __restrict__ b_ada, float* __restrict__ mod) {
    const int n = blockIdx.x * blockDim.x + threadIdx.x;
    const int r = blockIdx.y;
    const float* cond = r == 0 ? c_ctx : c + (size_t)(r - 1) * DM;
    float acc = 0.f;
    for (int k = 0; k < DM; ++k) acc += siluf(cond[k]) * w_ada[(size_t)k * 6144 + n];
    mod[r * 6144 + n] = acc + b_ada[n];
}

__global__ void k_modulate(const float* __restrict__ x, const float* __restrict__ g, const float* __restrict__ mod, int shift_off, int scale_off, int cls_base, int rows_per_cls, float* __restrict__ out) {
    __shared__ float red[4];
    const int row = blockIdx.x, tid = threadIdx.x;
    const int cls = cls_base + row / rows_per_cls;
    const float* xr = x + (size_t)row * DM;
    float v[4], s = 0.f;
#pragma unroll
    for (int j = 0; j < 4; ++j) { v[j] = xr[tid + 256 * j]; s += v[j] * v[j]; }
    s = wave_sum(s);
    if ((tid & 63) == 0) red[tid >> 6] = s;
    __syncthreads();
    const float tot = red[0] + red[1] + red[2] + red[3];
    const float rstd = rsqrtf(tot / DM + EPS);
#pragma unroll
    for (int j = 0; j < 4; ++j) { const int c = tid + 256 * j;
        out[(size_t)row * DM + c] = v[j] * rstd * g[c] * (1.f + mod[cls * 6144 + scale_off + c]) + mod[cls * 6144 + shift_off + c]; }
}

__global__ void __launch_bounds__(256) k_gemm(const float* __restrict__ A, const float* __restrict__ B, float* __restrict__ C, int M, int N, int K) {
    __shared__ float As[16][65];
    __shared__ float Bs[16][64];
    const int tid = threadIdx.x, tx = tid & 15, ty = tid >> 4;
    const int bm = blockIdx.y * 64, bn = blockIdx.x * 64;
    float acc[4][4];
#pragma unroll
    for (int i = 0; i < 4; ++i)
#pragma unroll
        for (int j = 0; j < 4; ++j) acc[i][j] = 0.f;
    for (int k0 = 0; k0 < K; k0 += 16) {
        { const int m = tid >> 2, kq = (tid & 3) * 4; const float4 a = *(const float4*)(A + (size_t)(bm + m) * K + k0 + kq);
          As[kq + 0][m] = a.x; As[kq + 1][m] = a.y; As[kq + 2][m] = a.z; As[kq + 3][m] = a.w; }
        { const int k = tid >> 4, nq = (tid & 15) * 4; const float4 b = *(const float4*)(B + (size_t)(k0 + k) * N + bn + nq);
          Bs[k][nq + 0] = b.x; Bs[k][nq + 1] = b.y; Bs[k][nq + 2] = b.z; Bs[k][nq + 3] = b.w; }
        __syncthreads();
#pragma unroll
        for (int k = 0; k < 16; ++k) {
            float a[4], b[4];
#pragma unroll
            for (int i = 0; i < 4; ++i) a[i] = As[k][ty * 4 + i];
#pragma unroll
            for (int j = 0; j < 4; ++j) b[j] = Bs[k][tx * 4 + j];
#pragma unroll
            for (int i = 0; i < 4; ++i)
#pragma unroll
                for (int j = 0; j < 4; ++j) acc[i][j] += a[i] * b[j];
        }
        __syncthreads();
    }
#pragma unroll
    for (int i = 0; i < 4; ++i) *(float4*)(C + (size_t)(bm + ty * 4 + i) * N + bn + tx * 4) = make_float4(acc[i][0], acc[i][1], acc[i][2], acc[i][3]);
}

__global__ void k_rope(float* __restrict__ proj, int rows) {
    const int idx = blockIdx.x * blockDim.x + threadIdx.x;
    if (idx >= rows * 10 * 32) return;
    const int pr = idx & 31, hh = (idx >> 5) % 10, row = idx / 320;
    const int t = row;
    const int half = pr >> 4, i = pr & 15;
    const float pos = half == 0 ? (float)(t / 64) : (float)(t % 64);
    const float inv = powf(10000.f, -(float)i / 16.f);
    const float ang = pos * inv;
    const float cs = cosf(ang), sn = sinf(ang);
    float* p = proj + (size_t)row * INW + hh * 64 + half * 32 + i;
    const float v1 = p[0], v2 = p[16];
    p[0] = v1 * cs - v2 * sn; p[16] = v1 * sn + v2 * cs;
}

__global__ void __launch_bounds__(64) k_attn(const float* __restrict__ proj, const float* __restrict__ ck, const float* __restrict__ cv, const float* __restrict__ sink, float* __restrict__ out, int rows, int L, int latent) {
    const int idx = blockIdx.x * blockDim.x + threadIdx.x;
    if (idx >= rows * 8) return;
    const int head = idx / rows, row = idx % rows, seq = row / L, i = row % L, kvh = head >> 2;
    float q[64], o[64];
    const float* qp = proj + (size_t)row * INW + head * 64;
#pragma unroll
    for (int d = 0; d < 64; ++d) { q[d] = qp[d] * 0.125f; o[d] = 0.f; }
    float m = sink[head], l = 1.f;
    const int j0 = latent ? (i - 128 < 0 ? 0 : i - 128) : 0, j1 = latent ? (i + 128 > L - 1 ? L - 1 : i + 128) : L - 1;
    for (int j = j0; j <= j1; ++j) {
        const float* kp = proj + (size_t)(seq * L + j) * INW + 512 + kvh * 64;
        const float* vp = kp + 128;
        float s = 0.f;
#pragma unroll
        for (int d = 0; d < 64; ++d) s += q[d] * kp[d];
        const float mn = fmaxf(m, s), corr = __expf(m - mn), p = __expf(s - mn);
        l = l * corr + p; m = mn;
#pragma unroll
        for (int d = 0; d < 64; ++d) o[d] = o[d] * corr + p * vp[d];
    }
    if (latent) for (int j = 0; j < 512; ++j) {
        const float* kp = ck + (size_t)(j * 2 + kvh) * 64;
        const float* vp = cv + (size_t)(j * 2 + kvh) * 64;
        float s = 0.f;
#pragma unroll
        for (int d = 0; d < 64; ++d) s += q[d] * kp[d];
        const float mn = fmaxf(m, s), corr = __expf(m - mn), p = __expf(s - mn);
        l = l * corr + p; m = mn;
#pragma unroll
        for (int d = 0; d < 64; ++d) o[d] = o[d] * corr + p * vp[d];
    }
    const float il = 1.f / l;
    float* op = out + (size_t)row * 512 + head * 64;
#pragma unroll
    for (int d = 0; d < 64; ++d) op[d] = o[d] * il;
}

struct SsmP { const float *lam_re, *lam_im, *log_dt, *b_re, *b_im, *c_re, *c_im, *d; };
__global__ void __launch_bounds__(64) k_ssm(const float* __restrict__ proj, SsmP P, const float* __restrict__ h0re, const float* __restrict__ h0im, float* __restrict__ yacc, float* __restrict__ fin_re, float* __restrict__ fin_im, int L) {
    const int seq = blockIdx.x >> 5, g = blockIdx.x & 31, n = threadIdx.x;
    for (int dr = 0; dr < 2; ++dr) {
        const int gi = dr * 32 + g;
        const float lr = P.lam_re[gi * 64 + n], li = P.lam_im[gi * 64 + n], dt = expf(P.log_dt[gi]);
        const float mag = expf(lr * dt), ang = li * dt, a_re = mag * cosf(ang), a_im = mag * sinf(ang);
        const float den = lr * lr + li * li, nr = a_re - 1.f;
        const float cf_re = (nr * lr + a_im * li) / den, cf_im = (a_im * lr - nr * li) / den;
        float bbr[16], bbi[16], cr[16], ci[16], dd[16];
#pragma unroll
        for (int p = 0; p < 16; ++p) {
            const float br = P.b_re[(size_t)(gi * 64 + n) * 16 + p], bi = P.b_im[(size_t)(gi * 64 + n) * 16 + p];
            bbr[p] = cf_re * br - cf_im * bi; bbi[p] = cf_re * bi + cf_im * br;
            cr[p] = P.c_re[(size_t)(gi * 16 + p) * 64 + n]; ci[p] = P.c_im[(size_t)(gi * 16 + p) * 64 + n];
            dd[p] = P.d[g * 16 + p];
        }
        float hr = 0.f, hi = 0.f;
        if (h0re) { hr = h0re[gi * 64 + n]; hi = h0im[gi * 64 + n]; }
        for (int step = 0; step < L; ++step) {
            const int t = dr == 0 ? step : L - 1 - step;
            const size_t row = (size_t)seq * L + t;
            const float* up = proj + row * INW + 768 + g * 16;
            float u[16], bur = 0.f, bui = 0.f;
#pragma unroll
            for (int p = 0; p < 16; ++p) { u[p] = up[p]; bur += bbr[p] * u[p]; bui += bbi[p] * u[p]; }
            const float nhr = a_re * hr - a_im * hi + bur, nhi = a_re * hi + a_im * hr + bui;
            hr = nhr; hi = nhi;
            float mine = 0.f;
#pragma unroll
            for (int p = 0; p < 16; ++p) { const float v = wave_sum(cr[p] * hr - ci[p] * hi); if (n == p) mine = v + (dr == 0 ? u[p] * dd[p] : 0.f); }
            if (n < 16) { float* yp = yacc + row * 512 + g * 16 + n; if (dr == 0) *yp = mine; else *yp += mine; }
        }
        if (fin_re) { fin_re[(size_t)(seq * 2 + dr) * 2048 + g * 64 + n] = hr; fin_im[(size_t)(seq * 2 + dr) * 2048 + g * 64 + n] = hi; }
        __syncthreads();
    }
}

__device__ __forceinline__ float gelu_tanh(float x) { const float u = 0.7978845608028654f * (x + 0.044715f * x * x * x); return 0.5f * x * (1.f + tanhf(u)); }
__global__ void k_glu(const float* __restrict__ yacc, const float* __restrict__ wglu, float* __restrict__ out, int rows) {
    const int idx = blockIdx.x * blockDim.x + threadIdx.x;
    if (idx >= rows * 512) return;
    const int row = idx >> 9, col = idx & 511, g = col >> 4, qq = col & 15;
    float z = 0.f, xq = 0.f;
#pragma unroll
    for (int p = 0; p < 16; ++p) { const float x = gelu_tanh(yacc[(size_t)row * 512 + g * 16 + p]); z += x * wglu[(g * 16 + p) * 16 + qq]; if (p == qq) xq = x; }
    out[idx] = xq / (1.f + __expf(-z));
}

__global__ void k_merge_norm(const float* __restrict__ attn, const float* __restrict__ ssm, const float* __restrict__ ga, const float* __restrict__ gs, float* __restrict__ a2) {
    __shared__ float red[4];
    const int row = blockIdx.x, tid = threadIdx.x;
    const bool isA = tid < 128; const int c0 = (tid & 127) * 4;
    const float* src = (isA ? attn : ssm) + (size_t)row * 512 + c0;
    const float4 v = *(const float4*)src;
    float s = v.x * v.x + v.y * v.y + v.z * v.z + v.w * v.w;
    s = wave_sum(s);
    if ((tid & 63) == 0) red[tid >> 6] = s;
    __syncthreads();
    const float tot = isA ? red[0] + red[1] : red[2] + red[3];
    const float rstd = rsqrtf(tot / 512.f + EPS);
    const float* gg = (isA ? ga : gs) + c0;
    float* dst = a2 + (size_t)row * DM + (isA ? 0 : 512) + c0;
    *(float4*)dst = make_float4(v.x * rstd * gg[0], v.y * rstd * gg[1], v.z * rstd * gg[2], v.w * rstd * gg[3]);
}

__global__ void k_resid(float* __restrict__ x, const float* __restrict__ tmp, const float* __restrict__ mod, int gate_off, int cls_base, int rows_per_cls, int rows) {
    const int idx = blockIdx.x * blockDim.x + threadIdx.x;
    if (idx >= rows * DM) return;
    const int row = idx >> 10, c = idx & 1023, cls = cls_base + row / rows_per_cls;
    x[idx] += mod[cls * 6144 + gate_off + c] * tmp[idx];
}

__global__ void k_conv_act(const float* __restrict__ up, const float* __restrict__ cw, const float* __restrict__ cb, float* __restrict__ act, int rows, int L) {
    const int idx = blockIdx.x * blockDim.x + threadIdx.x;
    if (idx >= rows * DFF) return;
    const int row = idx / DFF, f = idx % DFF, t = row % L;
    float g = cb[f], v = cb[DFF + f];
#pragma unroll
    for (int i = 0; i < 3; ++i) { const int tt = t + i - 1; if (tt < 0 || tt >= L) continue;
        const float* ur = up + (size_t)(row + i - 1) * 5632; g += ur[f] * cw[i * 5632 + f]; v += ur[DFF + f] * cw[i * 5632 + DFF + f]; }
    act[idx] = siluf(g) * v;
}

__global__ void k_final_norm(float* __restrict__ x, const float* __restrict__ g) {
    __shared__ float red[4];
    const int row = blockIdx.x, tid = threadIdx.x;
    float* xr = x + (size_t)row * DM;
    float v[4], s = 0.f;
#pragma unroll
    for (int j = 0; j < 4; ++j) { v[j] = xr[tid + 256 * j]; s += v[j] * v[j]; }
    s = wave_sum(s);
    if ((tid & 63) == 0) red[tid >> 6] = s;
    __syncthreads();
    const float rstd = rsqrtf((red[0] + red[1] + red[2] + red[3]) / DM + EPS);
#pragma unroll
    for (int j = 0; j < 4; ++j) xr[tid + 256 * j] = v[j] * rstd * g[tid + 256 * j];
}

__global__ void k_copy_kv(const float* __restrict__ proj, float* __restrict__ ok, float* __restrict__ ov) {
    const int idx = blockIdx.x * blockDim.x + threadIdx.x;
    const int row = idx >> 7, c = idx & 127;
    ok[idx] = proj[(size_t)row * INW + 512 + c]; ov[idx] = proj[(size_t)row * INW + 640 + c];
}
}

extern "C" void kernel_launch(void* const* d_in, const int* in_sizes, int n_in, void* d_out, int out_size, void* d_ws, size_t ws_size, hipStream_t stream) {
    using namespace ref;
    const float* x_prompt = (const float*)d_in[0]; const float* x_sample = (const float*)d_in[1];
    const float* cache_k = (const float*)d_in[2]; const float* cache_v = (const float*)d_in[3];
    const float* st_re = (const float*)d_in[4]; const float* st_im = (const float*)d_in[5];
    const float* c = (const float*)d_in[6]; const float* c_ctx = (const float*)d_in[7];
    const float* w_ada = (const float*)d_in[8]; const float* b_ada = (const float*)d_in[9];
    const float* g_norm1 = (const float*)d_in[10]; const float* g_norm2 = (const float*)d_in[11];
    const float* w_in = (const float*)d_in[12]; const float* sink = (const float*)d_in[13];
    SsmP P{(const float*)d_in[14], (const float*)d_in[15], (const float*)d_in[16], (const float*)d_in[17], (const float*)d_in[18], (const float*)d_in[19], (const float*)d_in[20], (const float*)d_in[21]};
    const float* wglu = (const float*)d_in[22]; const float* g_attn = (const float*)d_in[23]; const float* g_ssm = (const float*)d_in[24];
    const float* w_out = (const float*)d_in[25]; const float* w_up = (const float*)d_in[26]; const float* conv_w = (const float*)d_in[27];
    const float* conv_b = (const float*)d_in[28]; const float* w_down = (const float*)d_in[29]; const float* g_final = (const float*)d_in[30];
    float* out = (float*)d_out;
    float* X = out;
    float* o_k = out + 20971520; float* o_v = o_k + 524288; float* o_sre = o_v + 524288; float* o_sim = o_sre + 65536;
    float* ws = (float*)d_ws;
    const size_t R = 4096;
    float* MOD = ws;                    size_t off = 5 * 6144;
    off = 32768;
    float* H = ws + off;    off += R * 1024;
    float* PROJ = ws + off; float* UP = PROJ; off += R * 5632;
    float* ATT = PROJ + R * 1280; float* YACC = ATT + R * 512; float* SSM = YACC + R * 512; float* A2 = SSM + R * 512;
    float* TMP = ws + off;  off += R * 1024;
    float* ACT = ws + off;  off += R * 2816;
    if (off * 4 > ws_size) { fprintf(stderr, "ws too small\n"); return; }

    hipMemcpyAsync(X, x_prompt, (size_t)NCTX * DM * 4, hipMemcpyDeviceToDevice, stream);
    hipMemcpyAsync(X + (size_t)NCTX * DM, x_sample, (size_t)NLAT * DM * 4, hipMemcpyDeviceToDevice, stream);
    hipLaunchKernelGGL(k_adaln, dim3(6144 / 256, 5), dim3(256), 0, stream, c, c_ctx, w_ada, b_ada, MOD);
    for (int ch = 0; ch < 5; ++ch) {
        float* Xc = X + (size_t)ch * R * DM;
        const int latent = ch > 0, L = latent ? 4096 : 256, cls = ch;
        const int rows = (int)R;
        hipLaunchKernelGGL(k_modulate, dim3(rows), dim3(256), 0, stream, Xc, g_norm1, MOD, 0, 1024, cls, 1 << 30, H);
        hipLaunchKernelGGL(k_gemm, dim3(INW / 64, rows / 64), dim3(256), 0, stream, H, w_in, PROJ, rows, INW, DM);
        if (!latent) hipLaunchKernelGGL(k_copy_kv, dim3(rows * 128 / 256), dim3(256), 0, stream, PROJ, o_k, o_v);
        if (latent) hipLaunchKernelGGL(k_rope, dim3(rows * 320 / 256), dim3(256), 0, stream, PROJ, rows);
        const int b = ch - 1;
        hipLaunchKernelGGL(k_attn, dim3(rows * 8 / 64), dim3(64), 0, stream, PROJ, latent ? cache_k + (size_t)b * 512 * 128 : nullptr, latent ? cache_v + (size_t)b * 512 * 128 : nullptr, sink, ATT, rows, L, latent);
        hipLaunchKernelGGL(k_ssm, dim3((rows / L) * 32), dim3(64), 0, stream, PROJ, P, latent ? st_re + (size_t)b * 4096 : nullptr, latent ? st_im + (size_t)b * 4096 : nullptr, YACC, latent ? nullptr : o_sre, latent ? nullptr : o_sim, L);
        hipLaunchKernelGGL(k_glu, dim3(rows * 512 / 256), dim3(256), 0, stream, YACC, wglu, SSM, rows);
        hipLaunchKernelGGL(k_merge_norm, dim3(rows), dim3(256), 0, stream, ATT, SSM, g_attn, g_ssm, A2);
        hipLaunchKernelGGL(k_gemm, dim3(DM / 64, rows / 64), dim3(256), 0, stream, A2, w_out, TMP, rows, DM, DM);
        hipLaunchKernelGGL(k_resid, dim3(rows * DM / 256), dim3(256), 0, stream, Xc, TMP, MOD, 2048, cls, 1 << 30, rows);
        hipLaunchKernelGGL(k_modulate, dim3(rows), dim3(256), 0, stream, Xc, g_norm2, MOD, 3072, 4096, cls, 1 << 30, H);
        hipLaunchKernelGGL(k_gemm, dim3(5632 / 64, rows / 64), dim3(256), 0, stream, H, w_up, UP, rows, 5632, DM);
        hipLaunchKernelGGL(k_conv_act, dim3(rows * DFF / 256), dim3(256), 0, stream, UP, conv_w, conv_b, ACT, rows, L);
        hipLaunchKernelGGL(k_gemm, dim3(DM / 64, rows / 64), dim3(256), 0, stream, ACT, w_down, TMP, rows, DM, DFF);
        hipLaunchKernelGGL(k_resid, dim3(rows * DM / 256), dim3(256), 0, stream, Xc, TMP, MOD, 5120, cls, 1 << 30, rows);
        hipLaunchKernelGGL(k_final_norm, dim3(rows), dim3(256), 0, stream, Xc, g_final);
    }
}
```

```cpp
#include <hip/hip_runtime.h>
#include <cstdio>
#include <cstdint>
#include <cmath>
namespace pg8 {
#define PG8_LAS __attribute__((address_space(3)))
typedef unsigned short bf16_t;
typedef short bf16x8 __attribute__((ext_vector_type(8)));
typedef float f32x4 __attribute__((ext_vector_type(4)));
typedef unsigned u32x4 __attribute__((ext_vector_type(4)));
constexpr int BM = 256, BK = 64, HALF = 128, HTB = HALF * BK * 2  , STAGE_BYTES = 8 * HTB, NXCD = 8, WGM = 8;

__host__ __device__ __forceinline__ int lds_byte(int r, int c) { const int st = (r >> 4) * 2 + (c >> 5), rr = r & 15, cc = c & 31, ob = rr * 64 + cc * 2; return st * 1024 + (ob ^ (((ob >> 9) & 1) << 5)); }
__host__ __device__ __forceinline__ void stage_rc(int b, int& R, int& C) { const int st = b / 1024, sb = b % 1024, swz = sb ^ (((sb >> 9) & 1) << 5); R = (st >> 1) * 16 + swz / 64; C = (st & 1) * 32 + (swz % 64) / 2; }
__host__ __device__ __forceinline__ int perm32(int rho) { const int n = rho >> 4, i = rho & 15; return 8 * (i >> 2) + 4 * n + (i & 3); }

struct Unit { int pm, pn; };
struct Gemm { const bf16_t* A; const bf16_t* Bt; int M, N, K; };

struct StaticOrder {
    int nM, nN, nwg, G, c;
    __host__ __device__ void init(int M, int N, int G_, int c_) { nM = M / BM; nN = N / BM; nwg = nM * nN; G = G_; c = c_; }
    __host__ __device__ bool next(int i, Unit& u) const {
        const long L = (long)i * G + c; if (L >= nwg) return false;
        int wgid = (int)L; { const int q = nwg / NXCD, r = nwg % NXCD, xcd = wgid % NXCD, off = wgid / NXCD; wgid = (xcd < r ? xcd * (q + 1) : r * (q + 1) + (xcd - r) * q) + off; }
        const int nig = WGM * nN, gid = wgid / nig, fm = gid * WGM, gsz = (nM - fm) < WGM ? (nM - fm) : WGM;
        u.pm = fm + ((wgid % nig) % gsz); u.pn = (wgid % nig) / gsz; return true;
    }
    __device__ __forceinline__ void a_ready(const Unit&) const {}
    __device__ __forceinline__ void done(const Unit&) const {}
};

__device__ __forceinline__ unsigned cvt_pk_bf16(float lo, float hi) { unsigned r; asm volatile("v_cvt_pk_bf16_f32 %0, %1, %2" : "=v"(r) : "v"(lo), "v"(hi)); return r; }
typedef float f32x2 __attribute__((ext_vector_type(2)));
template <class Epi, class Sched, bool ALIGN_EPI = false, bool SP2 = false>
__device__ __forceinline__ void gemm_phase(PG8_LAS unsigned char* lds, const Gemm g, const Sched& S, const Epi& E) {
    const int tid = threadIdx.x, wid = __builtin_amdgcn_readfirstlane(tid >> 6), lane = tid & 63, wr = wid >> 2, wc = wid & 3, fr = lane & 15, fq = lane >> 4;
    const int K = g.K, nt = K / BK;
    unsigned voffA[2], voffB[2];
#pragma unroll
    for (int i = 0; i < 2; ++i) { int R, C; stage_rc(tid * 16 + i * 8192, R, C); const int Rb = Epi::PERM ? ((R & ~31) + perm32(R & 31)) : R;
        voffA[i] = (unsigned)(R * K + C) * 2u; voffB[i] = (unsigned)(Rb * K + C) * 2u; }
    const size_t kstep = (size_t)(BK * 2);
    const size_t hstep = (size_t)HALF * K * 2;
    const size_t tstep = 2 * hstep;
    const unsigned ldsw = (unsigned)wid * 1024u;
    const int aoff = lds_byte(wr * 64 + fr, fq * 8), boff = lds_byte(wc * 32 + fr, fq * 8);
#define PG8_SA(b, h) (((b) * 2 + (h)) * HTB)
#define PG8_SB(b, h) ((4 + (b) * 2 + (h)) * HTB)
#define PG8_STAGE(bufoff, gbase, voff) do { _Pragma("unroll") for (int _i = 0; _i < 2; ++_i) \
        __builtin_amdgcn_global_load_lds((const unsigned*)((const char*)(gbase) + (voff)[_i]), (PG8_LAS unsigned*)(lds + (bufoff) + ldsw + _i * 8192), 16, 0, 0); } while (0)
#define PG8_LDA(dst, b, h) do { _Pragma("unroll") for (int m = 0; m < 4; ++m) _Pragma("unroll") for (int k = 0; k < 2; ++k) dst[m][k] = *(const PG8_LAS bf16x8*)(lds + PG8_SA(b, h) + aoff + m * 2048 + k * 1024); } while (0)
#define PG8_LDB(dst, b, h) do { _Pragma("unroll") for (int n = 0; n < 2; ++n) _Pragma("unroll") for (int k = 0; k < 2; ++k) dst[n][k] = *(const PG8_LAS bf16x8*)(lds + PG8_SB(b, h) + boff + n * 2048 + k * 1024); } while (0)
#define PG8_MMA(ai, bj, At, Bt) do { __builtin_amdgcn_s_setprio(1); _Pragma("unroll") for (int m = 0; m < 4; ++m) _Pragma("unroll") for (int n = 0; n < 2; ++n) _Pragma("unroll") for (int k = 0; k < 2; ++k) \
        acc[ai][bj][m][n] = __builtin_amdgcn_mfma_f32_16x16x32_bf16(Bt[n][k], At[m][k], acc[ai][bj][m][n], 0, 0, 0); __builtin_amdgcn_s_setprio(0); } while (0)
#define PG8_WAIT_V(n) asm volatile("s_waitcnt vmcnt(" #n ")" ::: "memory")
#define PG8_WAIT_L(n) asm volatile("s_waitcnt lgkmcnt(" #n ")" ::: "memory")
#define PG8_BAR __builtin_amdgcn_s_barrier()
#define PG8_SCHED __builtin_amdgcn_sched_barrier(0)
    Unit cur, nxt; int ui = 0;
    if (!S.next(0, cur)) return;
    f32x4 acc[2][2][4][2];
#pragma unroll
    for (int a = 0; a < 2; ++a)
#pragma unroll
        for (int b = 0; b < 2; ++b)
#pragma unroll
            for (int m = 0; m < 4; ++m)
#pragma unroll
                for (int n = 0; n < 2; ++n) acc[a][b][m][n] = (f32x4){0.f, 0.f, 0.f, 0.f};
    bf16x8 At[4][2], B0[2][2], B1[2][2];
    const char* cA = (const char*)g.A + (size_t)cur.pm * tstep; const char* cB = (const char*)g.Bt + (size_t)cur.pn * tstep;
    S.a_ready(cur);
    if constexpr (SP2) {
        PG8_STAGE(PG8_SB(0, 0), cB, voffB); PG8_STAGE(PG8_SB(0, 1), cB + hstep, voffB); PG8_STAGE(PG8_SA(0, 0), cA, voffA); PG8_STAGE(PG8_SA(0, 1), cA + hstep, voffA);
        if (wr == 1) PG8_BAR;
        PG8_WAIT_V(2); PG8_BAR;
        PG8_STAGE(PG8_SB(1, 0), cB + kstep, voffB); PG8_STAGE(PG8_SA(1, 0), cA + kstep, voffA); PG8_STAGE(PG8_SB(1, 1), cB + hstep + kstep, voffB);
        PG8_WAIT_V(6); PG8_BAR;
    } else {
        PG8_STAGE(PG8_SB(0, 0), cB, voffB); PG8_STAGE(PG8_SA(0, 0), cA, voffA); PG8_STAGE(PG8_SB(0, 1), cB + hstep, voffB); PG8_STAGE(PG8_SA(0, 1), cA + hstep, voffA);
        if (wr == 1) PG8_BAR;
        PG8_WAIT_V(4); PG8_BAR;
        PG8_STAGE(PG8_SB(1, 0), cB + kstep, voffB); PG8_STAGE(PG8_SA(1, 0), cA + kstep, voffA); PG8_STAGE(PG8_SB(1, 1), cB + hstep + kstep, voffB);
        PG8_WAIT_V(6); PG8_BAR;
    }
    for (;;) {
        const bool has_next = S.next(ui + 1, nxt);
        const char* nA = has_next ? (const char*)g.A + (size_t)nxt.pm * tstep : cA; const char* nB = has_next ? (const char*)g.Bt + (size_t)nxt.pn * tstep : cB;
        for (int t = 0; t < nt; t += 2) {
            const bool last = (t == nt - 2);
            const char* a1 = cA + (size_t)(t + 1) * kstep;
            const char* a2 = last ? nA : cA + (size_t)(t + 2) * kstep; const char* b2 = last ? nB : cB + (size_t)(t + 2) * kstep;
            const char* a3 = a2 + kstep; const char* b3 = b2 + kstep;
            if (last && has_next) S.a_ready(nxt);
            if constexpr (SP2) {
            PG8_LDB(B0, 0, 0); PG8_LDB(B1, 0, 1); PG8_SCHED; PG8_LDA(At, 0, 0); PG8_STAGE(PG8_SA(1, 1), a1 + hstep, voffA);
            PG8_WAIT_V(8); PG8_WAIT_L(0); PG8_BAR; PG8_MMA(0, 0, At, B0); PG8_MMA(0, 1, At, B1); PG8_BAR; PG8_SCHED;
            PG8_LDA(At, 0, 1); PG8_STAGE(PG8_SB(0, 0), b2, voffB); PG8_STAGE(PG8_SB(0, 1), b2 + hstep, voffB); PG8_STAGE(PG8_SA(0, 0), a2, voffA);
            PG8_WAIT_V(8); PG8_WAIT_L(0); PG8_BAR; PG8_MMA(1, 0, At, B0); PG8_MMA(1, 1, At, B1); PG8_BAR; PG8_SCHED;
            PG8_LDB(B0, 1, 0); PG8_LDB(B1, 1, 1); PG8_SCHED; PG8_LDA(At, 1, 0); PG8_STAGE(PG8_SA(0, 1), a2 + hstep, voffA);
            PG8_WAIT_V(8); PG8_WAIT_L(0); PG8_BAR; PG8_MMA(0, 0, At, B0); PG8_MMA(0, 1, At, B1); PG8_BAR; PG8_SCHED;
            PG8_LDA(At, 1, 1); PG8_STAGE(PG8_SB(1, 0), b3, voffB); PG8_STAGE(PG8_SB(1, 1), b3 + hstep, voffB); PG8_STAGE(PG8_SA(1, 0), a3, voffA);
            PG8_WAIT_V(8); PG8_WAIT_L(0); PG8_BAR; PG8_MMA(1, 0, At, B0); PG8_MMA(1, 1, At, B1); PG8_BAR; PG8_SCHED;
            } else {
            PG8_LDB(B0, 0, 0); PG8_SCHED; PG8_LDA(At, 0, 0); PG8_STAGE(PG8_SA(1, 1), a1 + hstep, voffA);
            PG8_WAIT_L(8); PG8_BAR; PG8_WAIT_L(0); PG8_MMA(0, 0, At, B0); PG8_BAR; PG8_SCHED;
            PG8_LDB(B1, 0, 1); PG8_STAGE(PG8_SB(0, 0), b2, voffB);
            PG8_BAR; PG8_WAIT_L(0); PG8_MMA(0, 1, At, B1); PG8_BAR;
            PG8_LDA(At, 0, 1); PG8_STAGE(PG8_SA(0, 0), a2, voffA);
            PG8_BAR; PG8_WAIT_L(0); PG8_MMA(1, 0, At, B0); PG8_BAR; PG8_SCHED;
            PG8_STAGE(PG8_SB(0, 1), b2 + hstep, voffB);
            PG8_WAIT_V(6); PG8_BAR; PG8_MMA(1, 1, At, B1); PG8_BAR;
            PG8_LDB(B0, 1, 0); PG8_SCHED; PG8_LDA(At, 1, 0); PG8_STAGE(PG8_SA(0, 1), a2 + hstep, voffA);
            PG8_WAIT_L(8); PG8_BAR; PG8_WAIT_L(0); PG8_MMA(0, 0, At, B0); PG8_BAR; PG8_SCHED;
            PG8_LDB(B1, 1, 1); PG8_STAGE(PG8_SB(1, 0), b3, voffB);
            PG8_BAR; PG8_WAIT_L(0); PG8_MMA(0, 1, At, B1); PG8_BAR;
            PG8_LDA(At, 1, 1); PG8_STAGE(PG8_SA(1, 0), a3, voffA);
            PG8_BAR; PG8_WAIT_L(0); PG8_MMA(1, 0, At, B0); PG8_BAR; PG8_SCHED;
            PG8_STAGE(PG8_SB(1, 1), b3 + hstep, voffB);
            PG8_WAIT_V(6); PG8_BAR; PG8_MMA(1, 1, At, B1); PG8_BAR;
            }
        }
        if constexpr (ALIGN_EPI) { if (wr == 0) PG8_BAR; }
        if constexpr (!Epi::AFTER_DRAIN) { E(acc, cur, wr, wc, fr, fq); S.done(cur); }
        if (!has_next) break;
#pragma unroll
        for (int a = 0; a < 2; ++a)
#pragma unroll
            for (int b = 0; b < 2; ++b)
#pragma unroll
                for (int m = 0; m < 4; ++m)
#pragma unroll
                    for (int n = 0; n < 2; ++n) acc[a][b][m][n] = (f32x4){0.f, 0.f, 0.f, 0.f};
        cur = nxt; cA = nA; cB = nB; ++ui;
        if constexpr (ALIGN_EPI) { if (wr == 1) PG8_BAR; }
    }
    PG8_WAIT_V(0);
    if constexpr (!ALIGN_EPI) { if (wr == 0) PG8_BAR; }
    PG8_BAR;
    if constexpr (Epi::AFTER_DRAIN) { E.fused(acc, cur, wr, wc, fr, fq, lds, wid, lane); S.done(cur); }
#undef PG8_SA
#undef PG8_SB
#undef PG8_STAGE
#undef PG8_LDA
#undef PG8_LDB
#undef PG8_MMA
#undef PG8_WAIT_V
#undef PG8_WAIT_L
#undef PG8_BAR
#undef PG8_SCHED
}
}
#define GAS __attribute__((address_space(1)))
#define LAS __attribute__((address_space(3)))
typedef unsigned short bf16;
typedef unsigned v4u __attribute__((ext_vector_type(4)));
typedef float f32x4 __attribute__((ext_vector_type(4)));
typedef short bf16x8 __attribute__((ext_vector_type(8)));
typedef GAS unsigned gu32;
typedef GAS unsigned long long gu64;
#define RLX_AGENT __ATOMIC_RELAXED, __HIP_MEMORY_SCOPE_AGENT
#define LDS_WAIT() asm volatile("s_waitcnt lgkmcnt(0)" ::: "memory")
#define VM_WAIT() asm volatile("s_waitcnt vmcnt(0)" ::: "memory")
__device__ __forceinline__ unsigned long long rt() { return __builtin_amdgcn_s_memrealtime(); }
__device__ __forceinline__ unsigned f2bf(float f) { unsigned u = __builtin_bit_cast(unsigned, f); return (u + 0x7fffu + ((u >> 16) & 1u)) >> 16; }
__device__ __forceinline__ unsigned pk2(float lo, float hi) { return f2bf(lo) | (f2bf(hi) << 16); }

#define XB_TMO      128
#define XB_XCNT(j)  (256  + 64 * (j))
#define XB_XSUB(j)  (1280 + 64 * (j))
#define XB_XGEN(j)  (2304 + 64 * (j))
#define XB_TOP      3328
#define XB_TOPGEN   3392
#define XCD_BAR_WORDS 3456
#define XB_SPIN_CAP (1u << 18)

__device__ __forceinline__ unsigned xb_ld(unsigned* p)              { return __hip_atomic_load(p, __ATOMIC_RELAXED, __HIP_MEMORY_SCOPE_AGENT); }
__device__ __forceinline__ unsigned xb_add(unsigned* p, unsigned v) { return __hip_atomic_fetch_add(p, v, __ATOMIC_RELAXED, __HIP_MEMORY_SCOPE_AGENT); }
__device__ __forceinline__ unsigned xb_xcc_id() { return (unsigned)__builtin_amdgcn_s_getreg((3 << 11) | 20) & 0xFu; }
#define XB_SPIN(cond, bar) do { unsigned _sp = 0; while (cond) { __builtin_amdgcn_s_sleep(1); \
    if ((++_sp & 255u) == 0u) { if (xb_ld(&(bar)[XB_TMO])) break; if (_sp > XB_SPIN_CAP) { atomicAdd(&(bar)[XB_TMO], 1u); break; } } } } while (0)

struct XcdBarrier {
    unsigned* bar; unsigned x;
    volatile LAS unsigned* st;
};

__device__ __forceinline__ XcdBarrier xcd_barrier_post(unsigned* bar, volatile LAS unsigned* st) {
    XcdBarrier b; b.bar = bar; b.x = xb_xcc_id(); b.st = st;
    if (threadIdx.x == 0) (void)xb_add(&bar[XB_XCNT(b.x)], 1u);
    return b;
}
__device__ __forceinline__ void xcd_barrier_complete(unsigned* bar, unsigned x, unsigned& nloc, unsigned& nx) {
    const unsigned G = gridDim.x * gridDim.y * gridDim.z;
    unsigned sum, cnt, mine, sp = 0u;
    for (;;) {
        sum = 0u; cnt = 0u; mine = 0u;
#pragma unroll
        for (unsigned j = 0; j < 16; ++j) { const unsigned c = xb_ld(&bar[XB_XCNT(j)]); sum += c; cnt += (c > 0u) ? 1u : 0u; mine = (j == x) ? c : mine; }
        if (sum == G) break;
        __builtin_amdgcn_s_sleep(1);
        if ((++sp & 255u) == 0u) { if (xb_ld(&bar[XB_TMO])) break; if (sp > XB_SPIN_CAP) { atomicAdd(&bar[XB_TMO], 1u); break; } }
    }
    nloc = mine > 0u ? mine : 1u; nx = cnt > 0u ? cnt : 1u;
}

__device__ __forceinline__ void xcd_barrier(const XcdBarrier& b) {
    asm volatile("s_waitcnt vmcnt(0)" ::: "memory");
    __syncthreads();
    if (threadIdx.x == 0) {
        unsigned* bar = b.bar;
        __builtin_amdgcn_s_waitcnt(0);
        unsigned nloc = b.st[0], nx = b.st[1];
        if (nloc == 0u) { xcd_barrier_complete(bar, b.x, nloc, nx); b.st[0] = nloc; b.st[1] = nx; }
        const unsigned old = xb_add(&bar[XB_XSUB(b.x)], 1u);
        const unsigned gen = old / nloc;
        if (old + 1u == (gen + 1u) * nloc) {
            __builtin_amdgcn_fence(__ATOMIC_RELEASE, "agent");
            asm volatile("s_waitcnt vmcnt(0)" ::: "memory");
            const unsigned og = xb_add(&bar[XB_TOP], 1u);
            const unsigned tg = og / nx;
            if (og + 1u == (tg + 1u) * nx) xb_add(&bar[XB_TOPGEN], 1u);
            else XB_SPIN(xb_ld(&bar[XB_TOPGEN]) == tg, bar);
            __builtin_amdgcn_fence(__ATOMIC_ACQUIRE, "agent");
            xb_add(&bar[XB_XGEN(b.x)], 1u);
            asm volatile("s_waitcnt vmcnt(0)" ::: "memory");
        } else {
            XB_SPIN(xb_ld(&bar[XB_XGEN(b.x)]) == gen, bar);
            __builtin_amdgcn_fence(__ATOMIC_ACQUIRE, "agent");
            asm volatile("s_waitcnt vmcnt(0)" ::: "memory");
        }
    }
    __syncthreads();
}

constexpr int NWAVES = 8;
constexpr int DM = 1024, NCTX = 4096, NLAT = 16384, NTOK = 20480, INW = 1280, DFF = 2816, UPW = 5632;
constexpr float RMS_EPS = 1e-6f;
constexpr float LOG2E = 1.4426950408889634f;
constexpr float QSCALE = 0.125f * LOG2E;
constexpr int NSEG = 160;

constexpr size_t MiB = 1u << 20;
constexpr size_t WS_CTL = 0, CTL_ZERO_BYTES = 1 * MiB;
constexpr size_t WS_MOD = 1 * MiB;
constexpr size_t WS_ROPE = 1 * MiB + 128 * 1024;
constexpr size_t WS_SSMC = 1 * MiB + 256 * 1024;
constexpr size_t WS_SSMG = 2 * MiB + 256 * 1024;
constexpr size_t WS_ESEG = 2 * MiB + 512 * 1024;
constexpr size_t WS_CTXK = 8 * MiB, WS_CTXVT = 8 * MiB + 512 * 1024;
constexpr size_t WS_SB = 9 * MiB;
constexpr size_t WS_WIN = 16 * MiB, WS_WOUT = 19 * MiB, WS_WUP = 21 * MiB, WS_WDN = 32 * MiB;
constexpr size_t WS_XN = 38 * MiB;
constexpr size_t WS_R = 78 * MiB;
constexpr size_t WS_Q = WS_R, WS_K = WS_R + 20 * MiB, WS_VT = WS_R + 25 * MiB, WS_U = WS_R + 30 * MiB, WS_SS = WS_R + 50 * MiB, WS_AO = WS_R + 70 * MiB;
constexpr size_t WS_ACT = WS_R;
constexpr size_t WS_END = 188 * MiB;
constexpr int CW_BAR = 4096;

constexpr int RING_OFF = 0, RING_BYTES = 131072;
constexpr int LDSCTL_OFF = RING_BYTES, MISC_OFF = LDSCTL_OFF + 320;
constexpr int XBUF_OFF = RING_BYTES + 1024;
constexpr int LDS_BYTES = 147456;

typedef short bf16x4 __attribute__((ext_vector_type(4)));
typedef float f32x16 __attribute__((ext_vector_type(16)));
typedef unsigned u32x2 __attribute__((ext_vector_type(2)));
typedef float f32x2t __attribute__((ext_vector_type(2)));
typedef __bf16 bf16x2t __attribute__((ext_vector_type(2)));
__device__ __forceinline__ unsigned cvtpk(float lo, float hi) { f32x2t v = {lo, hi}; bf16x2t b = __builtin_convertvector(v, bf16x2t); return __builtin_bit_cast(unsigned, b); }
__device__ __forceinline__ float bf2f(unsigned short h) { return __builtin_bit_cast(float, (unsigned)h << 16); }
__device__ __forceinline__ float wave_sum(float v) {
#pragma unroll
    for (int o = 1; o < 64; o <<= 1) v += __shfl_xor(v, o);
    return v;
}
__device__ __forceinline__ float fast_sigmoid(float x) { return __builtin_amdgcn_rcpf(1.f + __builtin_amdgcn_exp2f(-x * LOG2E)); }
__device__ __forceinline__ float siluf(float x) { return x * fast_sigmoid(x); }
__device__ __forceinline__ float gelu_tanh(float x) { const float u = 0.7978845608028654f * (x + 0.044715f * x * x * x); return x * fast_sigmoid(2.f * u); }

struct Args {
    const float *x_prompt, *x_sample, *cache_k, *cache_v, *st_re, *st_im, *c, *c_ctx, *w_ada, *b_ada, *g_norm1, *g_norm2, *w_in, *sink;
    const float *lam_re, *lam_im, *log_dt, *b_re, *b_im, *c_re, *c_im, *ssm_d, *wglu, *g_attn, *g_ssm, *w_out, *w_up, *conv_w, *conv_b, *w_down, *g_final;
    float* out; unsigned char* ws; int ph_lo, ph_hi, li, pad;
};

struct Frame {
    LAS unsigned char* lds; volatile LAS unsigned* MISC; gu32* ctl;
    int tid, lane, wave, G;
};

__device__ __forceinline__ void transpose_item(const float* W, int K, int N, bf16* WT, int k0, int n0, int dst_row0, LAS float* scr, int lane) {
#pragma unroll 8
    for (int i = 0; i < 32; ++i) { const int kk = 2 * i + (lane >> 5); scr[kk * 33 + (lane & 31)] = W[(size_t)(k0 + kk) * N + n0 + (lane & 31)]; }
    LDS_WAIT(); asm volatile("" ::: "memory");
    const int c = lane & 7;
#pragma unroll
    for (int j = 0; j < 4; ++j) { const int n = (lane >> 3) + 8 * j; const LAS float* s = scr + (8 * c) * 33 + n;
        v4u o; o.x = pk2(s[0 * 33], s[1 * 33]); o.y = pk2(s[2 * 33], s[3 * 33]); o.z = pk2(s[4 * 33], s[5 * 33]); o.w = pk2(s[6 * 33], s[7 * 33]);
        *(GAS v4u*)(WT + (size_t)(dst_row0 + n) * K + k0 + 8 * c) = o; }
    LDS_WAIT(); asm volatile("" ::: "memory");
}

__device__ __forceinline__ void p0_setup(Frame& F, const Args& a) {
    unsigned char* ws = a.ws;
    float* MOD = (float*)(ws + WS_MOD);
    LAS float* ldsf = (LAS float*)F.lds;
    for (int u = blockIdx.x; u < 96; u += F.G) {
        LAS float* scond = ldsf; LAS float* red = ldsf + 5120;
        for (int i = F.tid; i < 5120; i += 512) { const int r = i >> 10, k = i & 1023; const float v = (r == 0) ? a.c_ctx[k] : a.c[(r - 1) * 1024 + k]; scond[i] = v / (1.f + __expf(-v)); }
        __syncthreads();
        const int n0 = u * 64, rg = F.lane >> 4, c4 = F.lane & 15;
        float acc[5][4];
#pragma unroll
        for (int r = 0; r < 5; ++r)
#pragma unroll
            for (int j = 0; j < 4; ++j) acc[r][j] = 0.f;
        const float* wp = a.w_ada + (size_t)(F.wave * 128 + rg) * 6144 + n0 + 4 * c4;
#pragma unroll 8
        for (int i = 0; i < 32; ++i) {
            const f32x4 w = *(const f32x4*)(wp + (size_t)i * 4 * 6144);
            const int k = F.wave * 128 + 4 * i + rg;
#pragma unroll
            for (int r = 0; r < 5; ++r) { const float s = scond[r * 1024 + k]; acc[r][0] += s * w.x; acc[r][1] += s * w.y; acc[r][2] += s * w.z; acc[r][3] += s * w.w; }
        }
#pragma unroll
        for (int r = 0; r < 5; ++r)
#pragma unroll
            for (int j = 0; j < 4; ++j) { float v = acc[r][j]; v += __shfl_xor(v, 16); v += __shfl_xor(v, 32); acc[r][j] = v; }
        if (rg == 0) {
#pragma unroll
            for (int r = 0; r < 5; ++r)
#pragma unroll
                for (int j = 0; j < 4; ++j) red[(F.wave * 5 + r) * 64 + 4 * c4 + j] = acc[r][j];
        }
        __syncthreads();
        if (F.tid < 320) { const int r = F.tid >> 6, cc = F.tid & 63; float s = a.b_ada[n0 + cc];
#pragma unroll
            for (int w = 0; w < 8; ++w) s += red[(w * 5 + r) * 64 + cc];
            MOD[r * 6144 + n0 + cc] = s; }
        __syncthreads();
    }
    __syncthreads();
    {
        LAS float* scr = (LAS float*)(F.lds + RING_OFF + F.wave * 16384);
        const int gw = (int)blockIdx.x * NWAVES + F.wave, NGW = F.G * NWAVES;
        constexpr int I_IN = 16 * 40, I_OUT = 16 * 32, I_UP = 16 * 176, I_DN = 44 * 32;
        constexpr int NITEMS = I_IN + I_OUT + I_UP + I_DN;
        for (int it = gw; it < NITEMS; it += NGW) {
            int r = it;
            if (r < I_IN) { const int kb = r / 40, nb = r % 40; transpose_item(a.w_in, 1024, 1280, (bf16*)(ws + WS_WIN), 64 * kb, 32 * nb, 32 * nb, scr, F.lane); continue; } r -= I_IN;
            if (r < I_OUT) { const int kb = r / 32, nb = r % 32; transpose_item(a.w_out, 1024, 1024, (bf16*)(ws + WS_WOUT), 64 * kb, 32 * nb, 32 * nb, scr, F.lane); continue; } r -= I_OUT;
            if (r < I_UP) { const int kb = r / 176, nb = r % 176; const int n0 = 32 * nb; const int half = n0 >= DFF ? 1 : 0; const int f = n0 - half * DFF;
                transpose_item(a.w_up, 1024, UPW, (bf16*)(ws + WS_WUP), 64 * kb, n0, 256 * (f >> 7) + 128 * half + (f & 127), scr, F.lane); continue; } r -= I_UP;
            { const int kb = r / 32, nb = r % 32; transpose_item(a.w_down, DFF, 1024, (bf16*)(ws + WS_WDN), 64 * kb, 32 * nb, 32 * nb, scr, F.lane); }
        }
    }
    {
        const int gt = ((int)blockIdx.x * NWAVES + F.wave) * 64 + F.lane, NGT = F.G * NWAVES * 64;
        float* RC = (float*)(ws + WS_ROPE); float* RS = RC + 1024;
        for (int i = gt; i < 1024; i += NGT) { const int pos = i >> 4, fi = i & 15; const float ang = (float)pos * powf(10000.f, -(float)fi / 16.f); RC[i] = cosf(ang); RS[i] = sinf(ang); }
        bf16* CK = (bf16*)(ws + WS_CTXK); bf16* CVT = (bf16*)(ws + WS_CTXVT);
        for (int i = gt; i < 4 * 512 * 128; i += NGT) {
            CK[i] = (bf16)f2bf(a.cache_k[i]);
            const int t = i & 511, d = (i >> 9) & 63, kvh = (i >> 15) & 1, b = i >> 16;
            CVT[i] = (bf16)f2bf(a.cache_v[((size_t)(b * 512 + t) * 2 + kvh) * 64 + d]);
        }
        const int gw = (int)blockIdx.x * NWAVES + F.wave, NGW = F.G * NWAVES;
        const int task = gw - (NGW - 64);
        if (task >= 0) {
            const int gi = task, g = gi & 31, n = F.lane;
            const float lr = a.lam_re[gi * 64 + n], li = a.lam_im[gi * 64 + n], dt = expf(a.log_dt[gi]);
            const float mag = expf(lr * dt), ang = li * dt, a_re = mag * cosf(ang), a_im = mag * sinf(ang);
            const float den = lr * lr + li * li, nr = a_re - 1.f;
            const float cf_re = (nr * lr + a_im * li) / den, cf_im = (a_im * lr - nr * li) / den;
            unsigned char* base = ws + WS_SSMC + (size_t)gi * 16384;
            bf16* BBm = (bf16*)base; bf16* CM = (bf16*)(base + 4096); float* AP = (float*)(base + 8192);
            const int c = n & 31, hi = n >> 5;
            for (int p = 0; p < 16; ++p) {
                const float br = a.b_re[(size_t)(gi * 64 + n) * 16 + p], bi = a.b_im[(size_t)(gi * 64 + n) * 16 + p];
                BBm[((2 * hi) * 32 + c) * 16 + p] = (bf16)f2bf(cf_re * br - cf_im * bi);
                BBm[((2 * hi + 1) * 32 + c) * 16 + p] = (bf16)f2bf(cf_re * bi + cf_im * br);
                CM[p * 128 + 4 * c + 2 * hi] = (bf16)f2bf(a.c_re[(size_t)(gi * 16 + p) * 64 + n]);
                CM[p * 128 + 4 * c + 2 * hi + 1] = (bf16)f2bf(-a.c_im[(size_t)(gi * 16 + p) * 64 + n]);
            }
            AP[n] = a_re; AP[64 + n] = a_im;
            { const float m16 = expf(lr * dt * 16.f), g16 = li * dt * 16.f; AP[128 + n] = m16 * cosf(g16); AP[192 + n] = m16 * sinf(g16); }
            { const float m128 = expf(lr * dt * 128.f), g128 = li * dt * 128.f; AP[256 + n] = m128 * cosf(g128); AP[320 + n] = m128 * sinf(g128); }
            if (gi < 32) {
                unsigned char* gb = ws + WS_SSMG + (size_t)g * 1024; bf16* WgT = (bf16*)gb; float* dd = (float*)(gb + 512);
                for (int e = n; e < 256; e += 64) { const int q = e >> 4, p = e & 15; WgT[q * 16 + p] = (bf16)f2bf(a.wglu[(g * 16 + p) * 16 + q]); }
                if (n < 16) dd[n] = a.ssm_d[g * 16 + n];
            }
        }
    }
}

__device__ __forceinline__ int row_cls(int row) { return row < NCTX ? 0 : 1 + ((row - NCTX) >> 12); }
__device__ __forceinline__ void p_modulate(Frame& F, const Args& a, int which) {
    const int gw = (int)blockIdx.x * NWAVES + F.wave, NGW = F.G * NWAVES;
    const float* MOD = (const float*)(a.ws + WS_MOD);
    const float* gn = which ? a.g_norm2 : a.g_norm1;
    const int sh_off = which ? 3072 : 0, sc_off = which ? 4096 : 1024;
    bf16* XN = (bf16*)(a.ws + WS_XN);
    for (int row = gw; row < NTOK; row += NGW) {
        const float* xr = which ? a.out + (size_t)row * DM : (row < NCTX ? a.x_prompt + (size_t)row * DM : a.x_sample + (size_t)(row - NCTX) * DM);
        const int cls = row_cls(row);
        f32x4 v[4]; float s = 0.f;
#pragma unroll
        for (int j = 0; j < 4; ++j) { v[j] = *(const f32x4*)(xr + 4 * F.lane + 256 * j); s += (v[j].x * v[j].x + v[j].y * v[j].y) + (v[j].z * v[j].z + v[j].w * v[j].w); }
        const float rstd = rsqrtf(wave_sum(s) * (1.f / DM) + RMS_EPS);
#pragma unroll
        for (int j = 0; j < 4; ++j) { const int c = 4 * F.lane + 256 * j;
            const f32x4 g = *(const f32x4*)(gn + c), sc = *(const f32x4*)(MOD + cls * 6144 + sc_off + c), sh = *(const f32x4*)(MOD + cls * 6144 + sh_off + c);
            const f32x4 o = v[j] * rstd * g * (sc + 1.f) + sh;
            u32x2 w; w.x = cvtpk(o.x, o.y); w.y = cvtpk(o.z, o.w);
            *(u32x2*)(XN + (size_t)row * DM + c) = w; }
    }
}

struct EpiInProj {
    static constexpr bool PERM = false, AFTER_DRAIN = false;
    bf16 *Q, *Kb, *VT, *U; float *ok, *ov; const float *RC, *RS;
    __device__ __forceinline__ void operator()(const f32x4 (&acc)[2][2][4][2], const pg8::Unit& u, int wr, int wc, int fr, int fq) const {
        const int rowt = u.pm * 256; const bool latent = rowt >= NCTX; const int half = wc & 1;
#pragma unroll
        for (int ai = 0; ai < 2; ++ai)
#pragma unroll
            for (int m = 0; m < 4; ++m) {
                const int row = rowt + ai * 128 + wr * 64 + m * 16 + fr;
                f32x4 cs = {1.f, 1.f, 1.f, 1.f}, sn = {0.f, 0.f, 0.f, 0.f};
                if (latent && u.pn <= 2) { const int t = (row - NCTX) & 4095; const int pos = half ? (t & 63) : (t >> 6); cs = *(const f32x4*)(RC + pos * 16 + 4 * fq); sn = *(const f32x4*)(RS + pos * 16 + 4 * fq); }
#pragma unroll
                for (int bj = 0; bj < 2; ++bj) {
                    const f32x4 v0 = acc[ai][bj][m][0], v1 = acc[ai][bj][m][1];
                    if (u.pn < 2) {
                        const f32x4 r0 = (v0 * cs - v1 * sn) * QSCALE, r1 = (v0 * sn + v1 * cs) * QSCALE;
                        bf16* p = Q + (size_t)row * 512 + u.pn * 256 + bj * 128 + wc * 32 + 4 * fq;
                        u32x2 w0, w1; w0.x = cvtpk(r0.x, r0.y); w0.y = cvtpk(r0.z, r0.w); w1.x = cvtpk(r1.x, r1.y); w1.y = cvtpk(r1.z, r1.w);
                        *(u32x2*)p = w0; *(u32x2*)(p + 16) = w1;
                    } else if (u.pn == 2) {
                        if (bj == 0) {
                            const f32x4 r0 = v0 * cs - v1 * sn, r1 = v0 * sn + v1 * cs;
                            const int col = wc * 32 + 4 * fq;
                            bf16* p = Kb + (size_t)row * 128 + col;
                            u32x2 w0, w1; w0.x = cvtpk(r0.x, r0.y); w0.y = cvtpk(r0.z, r0.w); w1.x = cvtpk(r1.x, r1.y); w1.y = cvtpk(r1.z, r1.w);
                            *(u32x2*)p = w0; *(u32x2*)(p + 16) = w1;
                            if (!latent) { *(f32x4*)(ok + (size_t)row * 128 + col) = v0; *(f32x4*)(ok + (size_t)row * 128 + col + 16) = v1; }
                        } else {
                            const int col = wc * 32 + 4 * fq;
                            bf16* p = VT + (size_t)col * NTOK + row;
                            p[0 * NTOK] = (bf16)f2bf(v0.x); p[1 * NTOK] = (bf16)f2bf(v0.y); p[2 * NTOK] = (bf16)f2bf(v0.z); p[3 * NTOK] = (bf16)f2bf(v0.w);
                            p[16 * NTOK] = (bf16)f2bf(v1.x); p[17 * NTOK] = (bf16)f2bf(v1.y); p[18 * NTOK] = (bf16)f2bf(v1.z); p[19 * NTOK] = (bf16)f2bf(v1.w);
                            if (!latent) { *(f32x4*)(ov + (size_t)row * 128 + col) = v0; *(f32x4*)(ov + (size_t)row * 128 + col + 16) = v1; }
                        }
                    } else {
                        bf16* p = U + (size_t)row * 512 + (u.pn - 3) * 256 + bj * 128 + wc * 32 + 4 * fq;
                        u32x2 w0, w1; w0.x = cvtpk(v0.x, v0.y); w0.y = cvtpk(v0.z, v0.w); w1.x = cvtpk(v1.x, v1.y); w1.y = cvtpk(v1.z, v1.w);
                        *(u32x2*)p = w0; *(u32x2*)(p + 16) = w1;
                    }
                }
            }
    }
};

template <bool IN_PLACE> struct EpiResid {
    static constexpr bool PERM = false, AFTER_DRAIN = false;
    const float *xp, *xs, *MOD; float* out; int gate_off;
    __device__ __forceinline__ void operator()(const f32x4 (&acc)[2][2][4][2], const pg8::Unit& u, int wr, int wc, int fr, int fq) const {
        const int rowt = u.pm * 256; const int cls = row_cls(rowt);
        const float* gp = MOD + cls * 6144 + gate_off + u.pn * 256 + wc * 32 + 4 * fq;
        f32x4 gt[2][2];
#pragma unroll
        for (int bj = 0; bj < 2; ++bj)
#pragma unroll
            for (int n = 0; n < 2; ++n) gt[bj][n] = *(const f32x4*)(gp + bj * 128 + n * 16);
#pragma unroll
        for (int ai = 0; ai < 2; ++ai)
#pragma unroll
            for (int m = 0; m < 4; ++m) {
                const int row = rowt + ai * 128 + wr * 64 + m * 16 + fr;
                const size_t off = (size_t)row * DM + u.pn * 256 + wc * 32 + 4 * fq;
                const float* xin = IN_PLACE ? out + off : (row < NCTX ? xp + off : xs + (off - (size_t)NCTX * DM));
#pragma unroll
                for (int bj = 0; bj < 2; ++bj)
#pragma unroll
                    for (int n = 0; n < 2; ++n) { const f32x4 xv = *(const f32x4*)(xin + bj * 128 + n * 16); *(f32x4*)(out + off + bj * 128 + n * 16) = xv + gt[bj][n] * acc[ai][bj][m][n]; }
            }
    }
};

struct EpiUpConv {
    static constexpr bool PERM = false, AFTER_DRAIN = false;
    bf16* ACT; float* SB; const float *cw, *cb; LAS float* xb;
    __device__ __forceinline__ void operator()(const f32x4 (&acc)[2][2][4][2], const pg8::Unit& u, int wr, int wc, int fr, int fq) const {
        const int lane = fr + 16 * fq;
        LAS float* xl = xb + (2 * wr) * 256 + wc * 32 + 4 * fq;
#pragma unroll
        for (int ai = 0; ai < 2; ++ai) { const int sp = 2 * ai + wr;
#pragma unroll
            for (int bj = 0; bj < 2; ++bj)
#pragma unroll
                for (int n = 0; n < 2; ++n) { const int tc = bj * 128 + wc * 32 + n * 16 + 4 * fq;
                    if (fr == 0) *(LAS f32x4*)(xl + (1 + 4 * ai) * 256 + bj * 128 + n * 16) = acc[ai][bj][0][n];
                    if (fr == 15) *(LAS f32x4*)(xl + (2 + 4 * ai) * 256 + bj * 128 + n * 16) = acc[ai][bj][3][n];
                    float* sb = SB + ((size_t)(u.pm * 22 + u.pn) * 4) * 256 + tc;
                    if (sp == 0 && fr < 2) *(f32x4*)(sb + fr * 256) = acc[ai][bj][0][n];
                    if (sp == 3 && fr >= 14) *(f32x4*)(sb + (fr - 12) * 256) = acc[ai][bj][3][n];
                } }
        asm volatile("s_waitcnt lgkmcnt(0)" ::: "memory"); __builtin_amdgcn_s_barrier(); asm volatile("" ::: "memory");
        const int lup = (lane & 48) | ((fr - 1) & 15), ldn = (lane & 48) | ((fr + 1) & 15);
        const int f0 = u.pn * 128 + wc * 32 + 4 * fq;
#pragma unroll
        for (int ai = 0; ai < 2; ++ai) { const int sp = 2 * ai + wr;
#pragma unroll
            for (int n = 0; n < 2; ++n) {
                f32x4 sg[4];
#pragma unroll
                for (int bj = 0; bj < 2; ++bj) { const int tc = bj * 128 + wc * 32 + n * 16 + 4 * fq; const int wi = bj * DFF + f0 + n * 16;
                    const f32x4 w0 = *(const f32x4*)(cw + wi), w1 = *(const f32x4*)(cw + UPW + wi), w2 = *(const f32x4*)(cw + 2 * UPW + wi), bb = *(const f32x4*)(cb + wi);
                    f32x4 pv = {0.f, 0.f, 0.f, 0.f}, nv = {0.f, 0.f, 0.f, 0.f};
                    if (sp > 0) pv = *(const LAS f32x4*)(xl + (4 * ai) * 256 + bj * 128 + n * 16);
                    if (sp < 3) nv = *(const LAS f32x4*)(xl + (3 + 4 * ai) * 256 + bj * 128 + n * 16);
#pragma unroll
                    for (int m = 0; m < 4; ++m) { const f32x4 cur = acc[ai][bj][m][n]; f32x4 up, dn;
#pragma unroll
                        for (int j = 0; j < 4; ++j) {
                            const float a_ = __shfl(cur[j], lup);
                            const float b_ = __shfl(cur[j], ldn);
                            const float pa = (m > 0) ? __shfl(acc[ai][bj][m > 0 ? m - 1 : 0][n][j], lup) : pv[j];
                            const float nb = (m < 3) ? __shfl(acc[ai][bj][m < 3 ? m + 1 : 3][n][j], ldn) : nv[j];
                            up[j] = fr == 0 ? pa : a_; dn[j] = fr == 15 ? nb : b_;
                        }
                        const f32x4 rs = w0 * up + w1 * cur + w2 * dn + bb;
                        if (bj == 0) { sg[m].x = siluf(rs.x); sg[m].y = siluf(rs.y); sg[m].z = siluf(rs.z); sg[m].w = siluf(rs.w); }
                        else { const int row = u.pm * 256 + ai * 128 + wr * 64 + m * 16 + fr;
                            u32x2 w; w.x = cvtpk(sg[m].x * rs.x, sg[m].y * rs.y); w.y = cvtpk(sg[m].z * rs.z, sg[m].w * rs.w);
                            *(u32x2*)(ACT + (size_t)row * DFF + f0 + n * 16) = w; }
                    }
                }
            } }
        asm volatile("s_waitcnt lgkmcnt(0)" ::: "memory"); __builtin_amdgcn_s_barrier(); asm volatile("" ::: "memory");
    }
};

__device__ __forceinline__ void p_conv_fix(Frame& F, const Args& a) {
    const int gt = ((int)blockIdx.x * NWAVES + F.wave) * 64 + F.lane, NGT = F.G * NWAVES * 64;
    const float* SB = (const float*)(a.ws + WS_SB); bf16* ACT = (bf16*)(a.ws + WS_ACT);
    const int total = 64 * 2 * DFF;
    for (int i = gt; i < total; i += NGT) {
        const int f = i % DFF, e = i / DFF, which = e & 1, pm = 16 + (e >> 1);
        const int tl = (pm - 16) & 15;
        const int pn = f >> 7, cc = f & 127;
        float gv[2];
#pragma unroll
        for (int bj = 0; bj < 2; ++bj) {
            const int tc = bj * 128 + cc, wi = bj * DFF + f;
            const float* s0 = SB + ((size_t)(pm * 22 + pn) * 4) * 256 + tc;
            float upv, cur, dnv;
            if (which == 0) { cur = s0[0]; dnv = s0[256]; upv = tl > 0 ? SB[((size_t)((pm - 1) * 22 + pn) * 4 + 3) * 256 + tc] : 0.f; }
            else { cur = s0[3 * 256]; upv = s0[2 * 256]; dnv = tl < 15 ? SB[((size_t)((pm + 1) * 22 + pn) * 4) * 256 + tc] : 0.f; }
            gv[bj] = a.conv_w[wi] * upv + a.conv_w[UPW + wi] * cur + a.conv_w[2 * UPW + wi] * dnv + a.conv_b[wi];
        }
        const int row = pm * 256 + (which ? 255 : 0);
        ACT[(size_t)row * DFF + f] = (bf16)f2bf(siluf(gv[0]) * gv[1]);
    }
}

__device__ __forceinline__ int crow(int r, int hh) { return (r & 3) + 8 * (r >> 2) + 4 * hh; }
struct AttnSt { float m, l; f32x16 o0, o1; };
template <bool MASK> __device__ __forceinline__ void attn_tile(AttnSt& st, const bf16x8 (&qf)[4], const bf16* kbase, const bf16* vtbase, int vds, int ts, int Lk, int qi, int ql, int hh) {
    f32x16 p0 = {}, p1 = {};
    {
        int k0 = ts + ql, k1 = ts + 32 + ql;
        k0 = k0 < 0 ? 0 : (k0 >= Lk ? Lk - 1 : k0); k1 = k1 < 0 ? 0 : (k1 >= Lk ? Lk - 1 : k1);
        const bf16* kp0 = kbase + (size_t)k0 * 128 + 8 * hh; const bf16* kp1 = kbase + (size_t)k1 * 128 + 8 * hh;
        bf16x8 ka[4], kb[4];
#pragma unroll
        for (int s = 0; s < 4; ++s) { ka[s] = *(const bf16x8*)(kp0 + 16 * s); kb[s] = *(const bf16x8*)(kp1 + 16 * s); }
#pragma unroll
        for (int s = 0; s < 4; ++s) { p0 = __builtin_amdgcn_mfma_f32_32x32x16_bf16(ka[s], qf[s], p0, 0, 0, 0); p1 = __builtin_amdgcn_mfma_f32_32x32x16_bf16(kb[s], qf[s], p1, 0, 0, 0); }
    }
    if (MASK) {
#pragma unroll
        for (int r = 0; r < 16; ++r) { const int key0 = ts + crow(r, hh), key1 = key0 + 32;
            const bool v0 = key0 >= 0 && key0 < Lk && key0 - qi >= -128 && key0 - qi <= 128;
            const bool v1 = key1 >= 0 && key1 < Lk && key1 - qi >= -128 && key1 - qi <= 128;
            p0[r] = v0 ? p0[r] : -1e30f; p1[r] = v1 ? p1[r] : -1e30f; }
    }
    float mt = p0[0];
#pragma unroll
    for (int r = 1; r < 16; ++r) mt = fmaxf(mt, p0[r]);
#pragma unroll
    for (int r = 0; r < 16; ++r) mt = fmaxf(mt, p1[r]);
    mt = fmaxf(mt, __shfl_xor(mt, 32));
    const float mn = fmaxf(st.m, mt), alpha = __builtin_amdgcn_exp2f(st.m - mn);
    st.m = mn;
    float ls = 0.f;
#pragma unroll
    for (int r = 0; r < 16; ++r) { p0[r] = __builtin_amdgcn_exp2f(p0[r] - mn); p1[r] = __builtin_amdgcn_exp2f(p1[r] - mn); ls += p0[r] + p1[r]; }
    st.l = st.l * alpha + ls;
    st.o0 = st.o0 * alpha; st.o1 = st.o1 * alpha;
#pragma unroll
    for (int kb = 0; kb < 2; ++kb)
#pragma unroll
        for (int s = 0; s < 2; ++s) {
            const f32x16& p = kb ? p1 : p0;
            v4u bw; bw.x = cvtpk(p[8 * s + 0], p[8 * s + 1]); bw.y = cvtpk(p[8 * s + 2], p[8 * s + 3]); bw.z = cvtpk(p[8 * s + 4], p[8 * s + 5]); bw.w = cvtpk(p[8 * s + 6], p[8 * s + 7]);
            const bf16x8 bfrag = __builtin_bit_cast(bf16x8, bw);
            int tok = ts + 32 * kb + 16 * s + 4 * hh;
            int tokb = tok + 8;
            tok = tok < 0 ? 0 : (tok >= Lk ? Lk - 4 : tok); tokb = tokb < 0 ? 0 : (tokb >= Lk ? Lk - 4 : tokb);
#pragma unroll
            for (int db = 0; db < 2; ++db) {
                const bf16* vp = vtbase + (size_t)(db * 32 + ql) * vds;
                const u32x2 lo = *(const u32x2*)(vp + tok), hi2 = *(const u32x2*)(vp + tokb);
                v4u aw; aw.x = lo.x; aw.y = lo.y; aw.z = hi2.x; aw.w = hi2.y;
                const bf16x8 afrag = __builtin_bit_cast(bf16x8, aw);
                if (db == 0) st.o0 = __builtin_amdgcn_mfma_f32_32x32x16_bf16(afrag, bfrag, st.o0, 0, 0, 0);
                else st.o1 = __builtin_amdgcn_mfma_f32_32x32x16_bf16(afrag, bfrag, st.o1, 0, 0, 0);
            }
        }
}

__device__ __forceinline__ void attn_unit(Frame& F, const Args& a, int is_lat, int b, int qb) {
    const int h = F.wave, kvh = h >> 2, ql = F.lane & 31, hh = F.lane >> 5;
    const int L = is_lat ? 4096 : 256, row0 = is_lat ? NCTX + b * 4096 : b * 256, q0 = qb * 32;
    const bf16* Q = (const bf16*)(a.ws + WS_Q); const bf16* Kb = (const bf16*)(a.ws + WS_K); const bf16* VT = (const bf16*)(a.ws + WS_VT);
    bf16x8 qf[4];
    { const bf16* qp = Q + (size_t)(row0 + q0 + ql) * 512 + h * 64 + 8 * hh;
#pragma unroll
      for (int s = 0; s < 4; ++s) qf[s] = *(const bf16x8*)(qp + 16 * s); }
    AttnSt st; st.m = a.sink[h] * LOG2E; st.l = hh == 0 ? 1.f : 0.f; st.o0 = f32x16{}; st.o1 = f32x16{};
    const bf16* kbase = Kb + (size_t)row0 * 128 + kvh * 64;
    const bf16* vtbase = VT + (size_t)(kvh * 64) * NTOK + row0;
    const int qi = q0 + ql;
    if (is_lat) {
        for (int t = 0; t < 5; ++t) attn_tile<true>(st, qf, kbase, vtbase, NTOK, q0 - 128 + 64 * t, L, qi, ql, hh);
        const bf16* ck = (const bf16*)(a.ws + WS_CTXK) + (size_t)b * 512 * 128 + kvh * 64;
        const bf16* cvt = (const bf16*)(a.ws + WS_CTXVT) + (size_t)(b * 2 + kvh) * 64 * 512;
        for (int t = 0; t < 8; ++t) attn_tile<false>(st, qf, ck, cvt, 512, 64 * t, 512, qi, ql, hh);
    } else {
        for (int t = 0; t < 4; ++t) attn_tile<false>(st, qf, kbase, vtbase, NTOK, 64 * t, L, qi, ql, hh);
    }
    const float lt = st.l + __shfl_xor(st.l, 32), inv = 1.f / lt;
    float ss = 0.f;
#pragma unroll
    for (int r = 0; r < 16; ++r) { st.o0[r] *= inv; st.o1[r] *= inv; ss += st.o0[r] * st.o0[r] + st.o1[r] * st.o1[r]; }
    ss += __shfl_xor(ss, 32);
    LAS float* sq = (LAS float*)F.lds;
    if (hh == 0) sq[h * 32 + ql] = ss;
    __syncthreads();
    float tot = 0.f;
#pragma unroll
    for (int w = 0; w < 8; ++w) tot += sq[w * 32 + ql];
    const float rstd = rsqrtf(tot * (1.f / 512.f) + RMS_EPS);
    bf16* AO = (bf16*)(a.ws + WS_AO) + (size_t)(row0 + q0 + ql) * DM + h * 64;
#pragma unroll
    for (int db = 0; db < 2; ++db)
#pragma unroll
        for (int rq = 0; rq < 4; ++rq) { const int d0 = 32 * db + 8 * rq + 4 * hh; const f32x4 g = *(const f32x4*)(a.g_attn + h * 64 + d0);
            const f32x16& o = db ? st.o1 : st.o0;
            u32x2 w; w.x = cvtpk(o[4 * rq] * rstd * g.x, o[4 * rq + 1] * rstd * g.y); w.y = cvtpk(o[4 * rq + 2] * rstd * g.z, o[4 * rq + 3] * rstd * g.w);
            *(u32x2*)(AO + d0) = w; }
    __syncthreads();
}

struct Cx { float r, i; };
__device__ __forceinline__ Cx cmul(Cx a, Cx b) { return Cx{a.r * b.r - a.i * b.i, a.r * b.i + a.i * b.r}; }
__device__ __forceinline__ Cx cfma(Cx a, Cx b, Cx c) { return Cx{a.r * b.r - a.i * b.i + c.r, a.r * b.i + a.i * b.r + c.i}; }
__device__ __forceinline__ Cx cshx(Cx a) { return Cx{__shfl_xor(a.r, 32), __shfl_xor(a.i, 32)}; }
struct SegInfo { int L, row0, nseg, segbase, sl, isl, seq; };
__device__ __forceinline__ SegInfo seg_info(int sg) {
    SegInfo s;
    if (sg < 32) { s.isl = 0; s.seq = sg >> 1; s.L = 256; s.row0 = s.seq * 256; s.nseg = 2; s.segbase = s.seq * 2; s.sl = sg & 1; }
    else { const int t = sg - 32; s.isl = 1; s.seq = t >> 5; s.L = 4096; s.row0 = NCTX + s.seq * 4096; s.nseg = 32; s.segbase = 32 + s.seq * 32; s.sl = t & 31; }
    return s;
}
__device__ __forceinline__ int bu_pos(int i) { return 16 * ((i >> 2) & 1) + (i & 3) + 4 * (i >> 3); }

__device__ __forceinline__ void ssm_pass_a(Frame& F, const Args& a, int unit) {
    const int sg = unit >> 6, gi = unit & 63, dr = gi >> 5, g = gi & 31;
    const SegInfo si = seg_info(sg);
    const int c = F.lane & 31, hh = F.lane >> 5;
    const unsigned char* cb = a.ws + WS_SSMC + (size_t)gi * 16384;
    const bf16* BBm = (const bf16*)cb; const float* AP = (const float*)(cb + 8192);
    bf16x8 bb[4];
#pragma unroll
    for (int q = 0; q < 4; ++q) bb[q] = *(const bf16x8*)(BBm + (q * 32 + c) * 16 + 8 * hh);
    const Cx a0{AP[c], AP[64 + c]}, a1{AP[32 + c], AP[96 + c]}, a16_0{AP[128 + c], AP[192 + c]}, a16_1{AP[160 + c], AP[224 + c]};
    const bf16* U = (const bf16*)(a.ws + WS_U);
    Cx S0{0.f, 0.f}, S1{0.f, 0.f};
    const int pi = bu_pos(c);
    for (int blk = 0; blk < 4; ++blk) {
        const int p = si.sl * 128 + blk * 32 + pi; const int tok = dr ? si.L - 1 - p : p;
        const bf16x8 ua = *(const bf16x8*)(U + (size_t)(si.row0 + tok) * 512 + g * 16 + 8 * hh);
        const f32x16 z = {};
        const f32x16 b0 = __builtin_amdgcn_mfma_f32_32x32x16_bf16(ua, bb[0], z, 0, 0, 0), b1 = __builtin_amdgcn_mfma_f32_32x32x16_bf16(ua, bb[1], z, 0, 0, 0);
        const f32x16 b2 = __builtin_amdgcn_mfma_f32_32x32x16_bf16(ua, bb[2], z, 0, 0, 0), b3 = __builtin_amdgcn_mfma_f32_32x32x16_bf16(ua, bb[3], z, 0, 0, 0);
        Cx e0{0.f, 0.f}, e1{0.f, 0.f};
#pragma unroll
        for (int r = 0; r < 16; ++r) { e0 = cfma(a0, e0, Cx{b0[r], b1[r]}); e1 = cfma(a1, e1, Cx{b2[r], b3[r]}); }
        const Cx x0 = cshx(e0), x1 = cshx(e1);
        const Cx E0a = hh ? x0 : e0, E1a = hh ? e0 : x0, E0b = hh ? x1 : e1, E1b = hh ? e1 : x1;
        S0 = cfma(a16_0, cfma(a16_0, S0, E0a), E1a);
        S1 = cfma(a16_1, cfma(a16_1, S1, E0b), E1b);
    }
    float* E = (float*)(a.ws + WS_ESEG) + ((size_t)sg * 64 + gi) * 128;
    if (hh == 0) { E[c] = S0.r; E[32 + c] = S0.i; E[64 + c] = S1.r; E[96 + c] = S1.i; }
}

__device__ __forceinline__ void ssm_pass_b(Frame& F, const Args& a, int unit) {
    const int tsg = unit >> 5, g = unit & 31;
    const SegInfo si = seg_info(tsg);
    const int c = F.lane & 31, hh = F.lane >> 5, t16 = F.lane & 15, kq = F.lane >> 4;
    const bf16* U = (const bf16*)(a.ws + WS_U);
    LAS unsigned char* Hl = F.lds + F.wave * 8704;
    f32x4 acc[4][2];
#pragma unroll
    for (int i = 0; i < 4; ++i) { acc[i][0] = f32x4{0.f, 0.f, 0.f, 0.f}; acc[i][1] = f32x4{0.f, 0.f, 0.f, 0.f}; }
    const unsigned char* gb = a.ws + WS_SSMG + (size_t)g * 1024;
    const bf16x4 wg = *(const bf16x4*)((const bf16*)gb + t16 * 16 + 4 * kq);
    const f32x4 dv = *(const f32x4*)((const float*)(gb + 512) + 4 * kq);
    bf16* SS = (bf16*)(a.ws + WS_SS);
    const int pi = bu_pos(c);
#pragma unroll
    for (int dr = 0; dr < 2; ++dr) {
        const int gi = dr * 32 + g;
        const unsigned char* cb = a.ws + WS_SSMC + (size_t)gi * 16384;
        const bf16* BBm = (const bf16*)cb; const bf16* CM = (const bf16*)(cb + 4096); const float* AP = (const float*)(cb + 8192);
        bf16x8 bb[4], cm[4];
#pragma unroll
        for (int q = 0; q < 4; ++q) { bb[q] = *(const bf16x8*)(BBm + (q * 32 + c) * 16 + 8 * hh); cm[q] = *(const bf16x8*)(CM + t16 * 128 + 32 * q + 8 * kq); }
        const Cx a0{AP[c], AP[64 + c]}, a1{AP[32 + c], AP[96 + c]}, a128_0{AP[256 + c], AP[320 + c]}, a128_1{AP[288 + c], AP[352 + c]};
        const int psl = dr ? si.nseg - 1 - si.sl : si.sl;
        Cx S0{0.f, 0.f}, S1{0.f, 0.f};
        if (si.isl) { const float* hr = a.st_re + (size_t)si.seq * 4096 + gi * 64; const float* hi_ = a.st_im + (size_t)si.seq * 4096 + gi * 64; S0 = Cx{hr[c], hi_[c]}; S1 = Cx{hr[32 + c], hi_[32 + c]}; }
        for (int ps = 0; ps < psl; ++ps) { const float* E = (const float*)(a.ws + WS_ESEG) + ((size_t)(si.segbase + ps) * 64 + gi) * 128;
            S0 = cfma(a128_0, S0, Cx{E[c], E[32 + c]}); S1 = cfma(a128_1, S1, Cx{E[64 + c], E[96 + c]}); }
#pragma unroll
        for (int blk = 0; blk < 4; ++blk) {
            const int tb = dr ? 3 - blk : blk;
            const int p = psl * 128 + blk * 32 + pi; const int tok = dr ? si.L - 1 - p : p;
            const bf16x8 ua = *(const bf16x8*)(U + (size_t)(si.row0 + tok) * 512 + g * 16 + 8 * hh);
#pragma unroll
            for (int nh = 0; nh < 2; ++nh) {
                const f32x16 z = {};
                f32x16 br = __builtin_amdgcn_mfma_f32_32x32x16_bf16(ua, bb[2 * nh], z, 0, 0, 0), bi = __builtin_amdgcn_mfma_f32_32x32x16_bf16(ua, bb[2 * nh + 1], z, 0, 0, 0);
                const Cx an = nh ? a1 : a0; Cx& S = nh ? S1 : S0;
                Cx h = hh ? Cx{0.f, 0.f} : S;
#pragma unroll
                for (int r = 0; r < 16; ++r) { h = cfma(an, h, Cx{br[r], bi[r]}); br[r] = h.r; bi[r] = h.i; }
                const Cx x = cshx(h);
                Cx pw = hh ? cmul(an, x) : Cx{0.f, 0.f};
#pragma unroll
                for (int r = 0; r < 16; ++r) { br[r] += pw.r; bi[r] += pw.i; pw = cmul(an, pw); }
                { const Cx e{br[15], bi[15]}; const Cx y = cshx(e); S = hh ? e : y; }
#pragma unroll
                for (int r = 0; r < 16; ++r) { const int pl = 16 * hh + r; const int tl = dr ? 31 - pl : pl;
                    *(LAS unsigned*)(Hl + tl * 272 + 8 * c + 4 * nh) = cvtpk(br[r], bi[r]); }
            }
            asm volatile("s_waitcnt lgkmcnt(0)" ::: "memory");
#pragma unroll
            for (int th = 0; th < 2; ++th)
#pragma unroll
                for (int ks = 0; ks < 4; ++ks) { const bf16x8 hf = *(const LAS bf16x8*)(Hl + (16 * th + t16) * 272 + (32 * ks + 8 * kq) * 2);
                    acc[tb][th] = __builtin_amdgcn_mfma_f32_16x16x32_bf16(cm[ks], hf, acc[tb][th], 0, 0, 0); }
            asm volatile("s_waitcnt lgkmcnt(0)" ::: "memory");
            if (dr == 1) {
#pragma unroll
                for (int th = 0; th < 2; ++th) {
                    const int tokn = si.sl * 128 + tb * 32 + 16 * th + t16;
                    const size_t ro = (size_t)(si.row0 + tokn) * 512 + g * 16 + 4 * kq;
                    const u32x2 uw = *(const u32x2*)(U + ro);
                    f32x4 y = acc[tb][th];
                    y.x += bf2f((unsigned short)(uw.x & 0xffffu)) * dv.x; y.y += bf2f((unsigned short)(uw.x >> 16)) * dv.y;
                    y.z += bf2f((unsigned short)(uw.y & 0xffffu)) * dv.z; y.w += bf2f((unsigned short)(uw.y >> 16)) * dv.w;
                    f32x4 x; x.x = gelu_tanh(y.x); x.y = gelu_tanh(y.y); x.z = gelu_tanh(y.z); x.w = gelu_tanh(y.w);
                    u32x2 xb; xb.x = cvtpk(x.x, x.y); xb.y = cvtpk(x.z, x.w);
                    const f32x4 zz = __builtin_amdgcn_mfma_f32_16x16x16bf16_1k(wg, __builtin_bit_cast(bf16x4, xb), f32x4{0.f, 0.f, 0.f, 0.f}, 0, 0, 0);
                    u32x2 ow; ow.x = cvtpk(x.x * fast_sigmoid(zz.x), x.y * fast_sigmoid(zz.y)); ow.y = cvtpk(x.z * fast_sigmoid(zz.z), x.w * fast_sigmoid(zz.w));
                    *(u32x2*)(SS + ro) = ow;
                }
            }
        }
        if (!si.isl && psl == si.nseg - 1 && hh == 0) {
            float* ore = a.out + 22020096 + (size_t)(si.seq * 2 + dr) * 2048 + g * 64; float* oim = ore + 65536;
            ore[c] = S0.r; ore[32 + c] = S1.r; oim[c] = S0.i; oim[32 + c] = S1.i;
        }
    }
}

__device__ __forceinline__ void p_ssm_norm(Frame& F, const Args& a) {
    const int gw = (int)blockIdx.x * NWAVES + F.wave, NGW = F.G * NWAVES;
    const bf16* SS = (const bf16*)(a.ws + WS_SS); bf16* AO = (bf16*)(a.ws + WS_AO);
    for (int row = gw; row < NTOK; row += NGW) {
        const v4u w = *(const v4u*)(SS + (size_t)row * 512 + 8 * F.lane);
        float v[8]; v[0] = bf2f(w.x & 0xffff); v[1] = bf2f(w.x >> 16); v[2] = bf2f(w.y & 0xffff); v[3] = bf2f(w.y >> 16); v[4] = bf2f(w.z & 0xffff); v[5] = bf2f(w.z >> 16); v[6] = bf2f(w.w & 0xffff); v[7] = bf2f(w.w >> 16);
        float s = 0.f;
#pragma unroll
        for (int j = 0; j < 8; ++j) s += v[j] * v[j];
        const float rstd = rsqrtf(wave_sum(s) * (1.f / 512.f) + RMS_EPS);
        const f32x4 g0 = *(const f32x4*)(a.g_ssm + 8 * F.lane), g1 = *(const f32x4*)(a.g_ssm + 8 * F.lane + 4);
        v4u o; o.x = cvtpk(v[0] * rstd * g0.x, v[1] * rstd * g0.y); o.y = cvtpk(v[2] * rstd * g0.z, v[3] * rstd * g0.w); o.z = cvtpk(v[4] * rstd * g1.x, v[5] * rstd * g1.y); o.w = cvtpk(v[6] * rstd * g1.z, v[7] * rstd * g1.w);
        *(v4u*)(AO + (size_t)row * DM + 512 + 8 * F.lane) = o;
    }
}

__device__ __forceinline__ void p_final_norm(Frame& F, const Args& a) {
    const int gw = (int)blockIdx.x * NWAVES + F.wave, NGW = F.G * NWAVES;
    for (int row = gw; row < NTOK; row += NGW) {
        float* xr = a.out + (size_t)row * DM;
        f32x4 v[4]; float s = 0.f;
#pragma unroll
        for (int j = 0; j < 4; ++j) { v[j] = *(const f32x4*)(xr + 4 * F.lane + 256 * j); s += (v[j].x * v[j].x + v[j].y * v[j].y) + (v[j].z * v[j].z + v[j].w * v[j].w); }
        const float rstd = rsqrtf(wave_sum(s) * (1.f / DM) + RMS_EPS);
#pragma unroll
        for (int j = 0; j < 4; ++j) { const f32x4 g = *(const f32x4*)(a.g_final + 4 * F.lane + 256 * j); *(f32x4*)(xr + 4 * F.lane + 256 * j) = v[j] * rstd * g; }
    }
}

#ifndef MK_PER_PHASE
#define MK_PER_PHASE 1
#endif
constexpr int N_PHASES = 12;
__global__ void __launch_bounds__(NWAVES * 64, 2) mega_fwd(Args args) {
    extern __shared__ __attribute__((aligned(16))) unsigned char lds[];
    Frame F;
    F.lds = (LAS unsigned char*)lds;
    F.MISC = (volatile LAS unsigned*)(F.lds + MISC_OFF);
    F.tid = threadIdx.x; F.lane = F.tid & 63; F.wave = __builtin_amdgcn_readfirstlane(F.tid >> 6);
    F.G = gridDim.x;
    F.ctl = (gu32*)(args.ws + WS_CTL);
    for (int u = F.tid; u < (LDS_BYTES - LDSCTL_OFF) / 4; u += NWAVES * 64) ((LAS unsigned*)(F.lds + LDSCTL_OFF))[u] = 0u;
    __syncthreads();
    XcdBarrier bar; bar.bar = (unsigned*)(F.ctl + CW_BAR); bar.x = 0; bar.st = nullptr;
    if (!MK_PER_PHASE) bar = xcd_barrier_post((unsigned*)(F.ctl + CW_BAR), F.MISC + 8);
#define GRID_BAR() do { if (!MK_PER_PHASE) xcd_barrier(bar); } while (0)
    const int lo = args.ph_lo, hi = args.ph_hi;
#ifndef MK_PHASE_MASK
#define MK_PHASE_MASK 0xFFF
#endif
#define IN(k) (((MK_PHASE_MASK >> (k)) & 1) && lo <= (k) && (k) < hi)
#define SEAM(k) do { if (IN(k) && IN((k) + 1)) GRID_BAR(); } while (0)
    unsigned char* ws = args.ws;

    if (IN(0)) { p0_setup(F, args); } SEAM(0);
    if (IN(1)) { p_modulate(F, args, 0); } SEAM(1);
    if (IN(2)) {
        pg8::Gemm g{(const pg8::bf16_t*)(ws + WS_XN), (const pg8::bf16_t*)(ws + WS_WIN), NTOK, INW, DM}; pg8::StaticOrder S; S.init(NTOK, INW, F.G, (int)blockIdx.x);
        EpiInProj E{(bf16*)(ws + WS_Q), (bf16*)(ws + WS_K), (bf16*)(ws + WS_VT), (bf16*)(ws + WS_U), args.out + 20971520, args.out + 21495808, (const float*)(ws + WS_ROPE), (const float*)(ws + WS_ROPE) + 1024};
        pg8::gemm_phase<EpiInProj, pg8::StaticOrder, true, true>(F.lds + RING_OFF, g, S, E);
    } SEAM(2);
    if (IN(3)) {
        const int gw = (int)blockIdx.x * NWAVES + F.wave, NGW = F.G * NWAVES;
        for (int u = gw; u < NSEG * 64; u += NGW) ssm_pass_a(F, args, u);
        __syncthreads();
        for (int u = blockIdx.x; u < 640; u += F.G) { if (u < 512) attn_unit(F, args, 1, u >> 7, u & 127); else attn_unit(F, args, 0, (u - 512) >> 3, (u - 512) & 7); }
    } SEAM(3);
    if (IN(4)) {
        const int gw = (int)blockIdx.x * NWAVES + F.wave, NGW = F.G * NWAVES;
        for (int u = gw; u < NSEG * 32; u += NGW) ssm_pass_b(F, args, u);
    } SEAM(4);
    if (IN(5)) { p_ssm_norm(F, args); } SEAM(5);
    if (IN(6)) {
        pg8::Gemm g{(const pg8::bf16_t*)(ws + WS_AO), (const pg8::bf16_t*)(ws + WS_WOUT), NTOK, DM, DM}; pg8::StaticOrder S; S.init(NTOK, DM, F.G, (int)blockIdx.x);
        EpiResid<false> E{args.x_prompt, args.x_sample, (const float*)(ws + WS_MOD), args.out, 2048};
        pg8::gemm_phase<EpiResid<false>, pg8::StaticOrder, true, true>(F.lds + RING_OFF, g, S, E);
    } SEAM(6);
    if (IN(7)) { p_modulate(F, args, 1); } SEAM(7);
    if (IN(8)) {
        pg8::Gemm g{(const pg8::bf16_t*)(ws + WS_XN), (const pg8::bf16_t*)(ws + WS_WUP), NTOK, UPW, DM}; pg8::StaticOrder S; S.init(NTOK, UPW, F.G, (int)blockIdx.x);
        EpiUpConv E{(bf16*)(ws + WS_ACT), (float*)(ws + WS_SB), args.conv_w, args.conv_b, (LAS float*)(F.lds + XBUF_OFF)};
        pg8::gemm_phase<EpiUpConv, pg8::StaticOrder, true, true>(F.lds + RING_OFF, g, S, E);
    } SEAM(8);
    if (IN(9)) { p_conv_fix(F, args); } SEAM(9);
    if (IN(10)) {
        pg8::Gemm g{(const pg8::bf16_t*)(ws + WS_ACT), (const pg8::bf16_t*)(ws + WS_WDN), NTOK, DM, DFF}; pg8::StaticOrder S; S.init(NTOK, DM, F.G, (int)blockIdx.x);
        EpiResid<true> E{nullptr, nullptr, (const float*)(ws + WS_MOD), args.out, 5120};
        pg8::gemm_phase<EpiResid<true>, pg8::StaticOrder, true, true>(F.lds + RING_OFF, g, S, E);
    } SEAM(10);
    if (IN(11)) { p_final_norm(F, args); }
#undef IN
#undef SEAM
}

extern "C" void kernel_launch(void* const* d_in, const int* in_sizes, int n_in, void* d_out, int out_size, void* d_ws, size_t ws_size, hipStream_t stream) {
    static int grid = 0;
    if (grid == 0) {
        if (n_in != 31 || ws_size < WS_END) { fprintf(stderr, "kernel_launch: unexpected inputs (n_in %d, ws %zu)\n", n_in, ws_size); grid = -1; return; }
        int dev = 0, cus = 0, per_cu = 0;
        if (hipGetDevice(&dev) != hipSuccess || hipDeviceGetAttribute(&cus, hipDeviceAttributeMultiprocessorCount, dev) != hipSuccess) { grid = -1; return; }
        if (hipFuncSetAttribute((const void*)mega_fwd, hipFuncAttributeMaxDynamicSharedMemorySize, LDS_BYTES) != hipSuccess) { fprintf(stderr, "kernel_launch: hipFuncSetAttribute failed\n"); grid = -1; return; }
        if (hipOccupancyMaxActiveBlocksPerMultiprocessor(&per_cu, (const void*)mega_fwd, NWAVES * 64, LDS_BYTES) != hipSuccess || per_cu < 1) fprintf(stderr, "kernel_launch: occupancy query reports %d\n", per_cu);
        (void)hipGetLastError();
        grid = cus;
    }
    if (grid < 0) return;
    if (hipMemsetAsync((char*)d_ws + WS_CTL, 0, CTL_ZERO_BYTES, stream) != hipSuccess) return;
    Args a{};
    const float** ap = (const float**)&a;
    for (int i = 0; i < 31; ++i) ap[i] = (const float*)d_in[i];
    a.out = (float*)d_out; a.ws = (unsigned char*)d_ws;
#if MK_PER_PHASE
    for (int p = 0; p < N_PHASES; ++p) { a.ph_lo = p; a.ph_hi = p + 1; a.li = 0; hipLaunchKernelGGL(mega_fwd, dim3(grid), dim3(NWAVES * 64), LDS_BYTES, stream, a); }
#else
    a.ph_lo = 0; a.ph_hi = N_PHASES; a.li = 0;
    hipLaunchKernelGGL(mega_fwd, dim3(grid), dim3(NWAVES * 64), LDS_BYTES, stream, a);
#endif
}
```

```cpp
#include <hip/hip_runtime.h>
#include <cstdio>
#include <cstdint>
#include <cmath>
__device__ __forceinline__ void mk_sync() { __builtin_amdgcn_fence(__ATOMIC_RELEASE, "workgroup"); __builtin_amdgcn_s_barrier(); __builtin_amdgcn_fence(__ATOMIC_ACQUIRE, "workgroup"); }
#define __syncthreads mk_sync
#ifndef MK_EPI_DRAIN
#define MK_EPI_DRAIN 0
#endif
namespace pg8 {
#define PG8_LAS __attribute__((address_space(3)))
typedef unsigned short bf16_t;
typedef short bf16x8 __attribute__((ext_vector_type(8)));
typedef float f32x4 __attribute__((ext_vector_type(4)));
typedef unsigned u32x4 __attribute__((ext_vector_type(4)));
constexpr int BM = 256, BK = 64, HALF = 128, HTB = HALF * BK * 2  , STAGE_BYTES = 8 * HTB, NXCD = 8, WGM = 8;

__host__ __device__ __forceinline__ int lds_byte(int r, int c) { const int st = (r >> 4) * 2 + (c >> 5), rr = r & 15, cc = c & 31, ob = rr * 64 + cc * 2; return st * 1024 + (ob ^ (((ob >> 9) & 1) << 5)); }
__host__ __device__ __forceinline__ void stage_rc(int b, int& R, int& C) { const int st = b / 1024, sb = b % 1024, swz = sb ^ (((sb >> 9) & 1) << 5); R = (st >> 1) * 16 + swz / 64; C = (st & 1) * 32 + (swz % 64) / 2; }
__host__ __device__ __forceinline__ int perm32(int rho) { const int n = rho >> 4, i = rho & 15; return 8 * (i >> 2) + 4 * n + (i & 3); }

struct Unit { int pm, pn, hm; };
struct Gemm { const bf16_t* A; const bf16_t* Bt; int M, N, K; };

struct StaticOrder {
    static constexpr bool HALVES = false;
    int nM, nN, nwg, G, c;
    __host__ __device__ void init(int M, int N, int G_, int c_) { nM = M / BM; nN = N / BM; nwg = nM * nN; G = G_; c = c_; }
    __host__ __device__ bool next(int i, Unit& u) const {
        const long L = (long)i * G + c; if (L >= nwg) return false;
        int wgid = (int)L; { const int q = nwg / NXCD, r = nwg % NXCD, xcd = wgid % NXCD, off = wgid / NXCD; wgid = (xcd < r ? xcd * (q + 1) : r * (q + 1) + (xcd - r) * q) + off; }
        const int nig = WGM * nN, gid = wgid / nig, fm = gid * WGM, gsz = (nM - fm) < WGM ? (nM - fm) : WGM;
        u.pm = fm + ((wgid % nig) % gsz); u.pn = (wgid % nig) / gsz; u.hm = -1; return true;
    }
    __device__ __forceinline__ void a_ready(const Unit&) const {}
    __device__ __forceinline__ void done(const Unit&) const {}
};

__device__ __forceinline__ unsigned cvt_pk_bf16(float lo, float hi) { unsigned r; asm volatile("v_cvt_pk_bf16_f32 %0, %1, %2" : "=v"(r) : "v"(lo), "v"(hi)); return r; }
typedef float f32x2 __attribute__((ext_vector_type(2)));
template <class Epi, class Sched, bool ALIGN_EPI = false, bool SP2 = false>
__device__ __forceinline__ void gemm_phase(PG8_LAS unsigned char* lds, const Gemm g, const Sched& S, const Epi& E) {
    const int tid = threadIdx.x, wid = __builtin_amdgcn_readfirstlane(tid >> 6), lane = tid & 63, wr = wid >> 2, wc = wid & 3, fr = lane & 15, fq = lane >> 4;
    const int K = g.K, nt = K / BK;
    unsigned voffA[2], voffB[2];
#pragma unroll
    for (int i = 0; i < 2; ++i) { int R, C; stage_rc(tid * 16 + i * 8192, R, C); const int Rb = Epi::PERM ? ((R & ~31) + perm32(R & 31)) : R;
        voffA[i] = (unsigned)(R * K + C) * 2u; voffB[i] = (unsigned)(Rb * K + C) * 2u; }
    const size_t kstep = (size_t)(BK * 2);
    const size_t hstep = (size_t)HALF * K * 2;
    const size_t tstep = 2 * hstep;
    const unsigned ldsw = (unsigned)wid * 1024u;
    const int aoff = lds_byte(wr * 64 + fr, fq * 8), boff = lds_byte(wc * 32 + fr, fq * 8);
#define PG8_SA(b, h) (((b) * 2 + (h)) * HTB)
#define PG8_SB(b, h) ((4 + (b) * 2 + (h)) * HTB)
#define PG8_STAGE(bufoff, gbase, voff) do { _Pragma("unroll") for (int _i = 0; _i < 2; ++_i) \
        __builtin_amdgcn_global_load_lds((const unsigned*)((const char*)(gbase) + (voff)[_i]), (PG8_LAS unsigned*)(lds + (bufoff) + ldsw + _i * 8192), 16, 0, 0); } while (0)
#define PG8_LDA(dst, b, h) do { _Pragma("unroll") for (int m = 0; m < 4; ++m) _Pragma("unroll") for (int k = 0; k < 2; ++k) dst[m][k] = *(const PG8_LAS bf16x8*)(lds + PG8_SA(b, h) + aoff + m * 2048 + k * 1024); } while (0)
#define PG8_LDB(dst, b, h) do { _Pragma("unroll") for (int n = 0; n < 2; ++n) _Pragma("unroll") for (int k = 0; k < 2; ++k) dst[n][k] = *(const PG8_LAS bf16x8*)(lds + PG8_SB(b, h) + boff + n * 2048 + k * 1024); } while (0)
#define PG8_MMA(ai, bj, At, Bt) do { __builtin_amdgcn_s_setprio(1); _Pragma("unroll") for (int m = 0; m < 4; ++m) _Pragma("unroll") for (int n = 0; n < 2; ++n) _Pragma("unroll") for (int k = 0; k < 2; ++k) \
        acc[ai][bj][m][n] = __builtin_amdgcn_mfma_f32_16x16x32_bf16(Bt[n][k], At[m][k], acc[ai][bj][m][n], 0, 0, 0); __builtin_amdgcn_s_setprio(0); } while (0)
#define PG8_WAIT_V(n) asm volatile("s_waitcnt vmcnt(" #n ")" ::: "memory")
#define PG8_WAIT_L(n) asm volatile("s_waitcnt lgkmcnt(" #n ")" ::: "memory")
#define PG8_BAR __builtin_amdgcn_s_barrier()
#define PG8_SCHED __builtin_amdgcn_sched_barrier(0)
    Unit cur, nxt; int ui = 0;
    if (!S.next(0, cur)) return;
    f32x4 acc[2][2][4][2];
#pragma unroll
    for (int a = 0; a < 2; ++a)
#pragma unroll
        for (int b = 0; b < 2; ++b)
#pragma unroll
            for (int m = 0; m < 4; ++m)
#pragma unroll
                for (int n = 0; n < 2; ++n) acc[a][b][m][n] = (f32x4){0.f, 0.f, 0.f, 0.f};
    bf16x8 At[4][2], B0[2][2], B1[2][2];
    const char* cA = (const char*)g.A + (size_t)cur.pm * tstep; const char* cB = (const char*)g.Bt + (size_t)cur.pn * tstep;
    constexpr bool HV = Sched::HALVES;
    size_t cah = hstep;
    if constexpr (HV) { if (cur.hm >= 0) { cah = 0; cA += (size_t)cur.hm * hstep; } }
    S.a_ready(cur); S.unit_begin(cur); if constexpr (Epi::HAS_BEGIN) E.begin(cur);
    if constexpr (SP2) {
        PG8_STAGE(PG8_SB(0, 0), cB, voffB); PG8_STAGE(PG8_SB(0, 1), cB + hstep, voffB); PG8_STAGE(PG8_SA(0, 0), cA, voffA); PG8_STAGE(PG8_SA(0, 1), cA + cah, voffA);
        if (wr == 1) PG8_BAR;
        PG8_WAIT_V(2); PG8_BAR;
        PG8_STAGE(PG8_SB(1, 0), cB + kstep, voffB); PG8_STAGE(PG8_SA(1, 0), cA + kstep, voffA); PG8_STAGE(PG8_SB(1, 1), cB + hstep + kstep, voffB);
        PG8_WAIT_V(6); PG8_BAR;
    } else {
        PG8_STAGE(PG8_SB(0, 0), cB, voffB); PG8_STAGE(PG8_SA(0, 0), cA, voffA); PG8_STAGE(PG8_SB(0, 1), cB + hstep, voffB); PG8_STAGE(PG8_SA(0, 1), cA + cah, voffA);
        if (wr == 1) PG8_BAR;
        PG8_WAIT_V(4); PG8_BAR;
        PG8_STAGE(PG8_SB(1, 0), cB + kstep, voffB); PG8_STAGE(PG8_SA(1, 0), cA + kstep, voffA); PG8_STAGE(PG8_SB(1, 1), cB + hstep + kstep, voffB);
        PG8_WAIT_V(6); PG8_BAR;
    }
    for (;;) {
        const bool has_next = S.next(ui + 1, nxt);
        const char* nA = has_next ? (const char*)g.A + (size_t)nxt.pm * tstep : cA; const char* nB = has_next ? (const char*)g.Bt + (size_t)nxt.pn * tstep : cB;
        size_t nah = has_next ? hstep : cah;
        if constexpr (HV) { if (has_next && nxt.hm >= 0) { nah = 0; nA += (size_t)nxt.hm * hstep; } }
        const bool full = !HV || cur.hm < 0;
        for (int t = 0; t < nt; t += 2) {
            const bool last = (t == nt - 2);
            if constexpr (Epi::MID > 0) { if (t == Epi::MID) E.mid(acc, wr, fr); }
            const char* a1 = cA + (size_t)(t + 1) * kstep;
            const char* a2 = last ? nA : cA + (size_t)(t + 2) * kstep; const char* b2 = last ? nB : cB + (size_t)(t + 2) * kstep;
            const char* a3 = a2 + kstep; const char* b3 = b2 + kstep;
            if (last && has_next) S.a_ready(nxt);
            if constexpr (SP2) {
            PG8_LDB(B0, 0, 0); PG8_LDB(B1, 0, 1); PG8_SCHED; PG8_LDA(At, 0, 0); PG8_STAGE(PG8_SA(1, 1), a1 + cah, voffA);
            PG8_WAIT_V(8); PG8_WAIT_L(0); PG8_BAR; PG8_MMA(0, 0, At, B0); PG8_MMA(0, 1, At, B1); PG8_BAR; PG8_SCHED;
            PG8_LDA(At, 0, 1); PG8_STAGE(PG8_SB(0, 0), b2, voffB); PG8_STAGE(PG8_SB(0, 1), b2 + hstep, voffB); PG8_STAGE(PG8_SA(0, 0), a2, voffA);
            PG8_WAIT_V(8); PG8_WAIT_L(0); PG8_BAR; if (full) { PG8_MMA(1, 0, At, B0); PG8_MMA(1, 1, At, B1); } PG8_BAR; PG8_SCHED;
            PG8_LDB(B0, 1, 0); PG8_LDB(B1, 1, 1); PG8_SCHED; PG8_LDA(At, 1, 0); PG8_STAGE(PG8_SA(0, 1), a2 + (last ? nah : cah), voffA);
            PG8_WAIT_V(8); PG8_WAIT_L(0); PG8_BAR; PG8_MMA(0, 0, At, B0); PG8_MMA(0, 1, At, B1); PG8_BAR; PG8_SCHED;
            PG8_LDA(At, 1, 1); PG8_STAGE(PG8_SB(1, 0), b3, voffB); PG8_STAGE(PG8_SB(1, 1), b3 + hstep, voffB); PG8_STAGE(PG8_SA(1, 0), a3, voffA);
            PG8_WAIT_V(8); PG8_WAIT_L(0); PG8_BAR; if (full) { PG8_MMA(1, 0, At, B0); PG8_MMA(1, 1, At, B1); } PG8_BAR; PG8_SCHED;
            } else {
            PG8_LDB(B0, 0, 0); PG8_SCHED; PG8_LDA(At, 0, 0); PG8_STAGE(PG8_SA(1, 1), a1 + hstep, voffA);
            PG8_WAIT_L(8); PG8_BAR; PG8_WAIT_L(0); PG8_MMA(0, 0, At, B0); PG8_BAR; PG8_SCHED;
            PG8_LDB(B1, 0, 1); PG8_STAGE(PG8_SB(0, 0), b2, voffB);
            PG8_BAR; PG8_WAIT_L(0); PG8_MMA(0, 1, At, B1); PG8_BAR;
            PG8_LDA(At, 0, 1); PG8_STAGE(PG8_SA(0, 0), a2, voffA);
            PG8_BAR; PG8_WAIT_L(0); PG8_MMA(1, 0, At, B0); PG8_BAR; PG8_SCHED;
            PG8_STAGE(PG8_SB(0, 1), b2 + hstep, voffB);
            PG8_WAIT_V(6); PG8_BAR; PG8_MMA(1, 1, At, B1); PG8_BAR;
            PG8_LDB(B0, 1, 0); PG8_SCHED; PG8_LDA(At, 1, 0); PG8_STAGE(PG8_SA(0, 1), a2 + hstep, voffA);
            PG8_WAIT_L(8); PG8_BAR; PG8_WAIT_L(0); PG8_MMA(0, 0, At, B0); PG8_BAR; PG8_SCHED;
            PG8_LDB(B1, 1, 1); PG8_STAGE(PG8_SB(1, 0), b3, voffB);
            PG8_BAR; PG8_WAIT_L(0); PG8_MMA(0, 1, At, B1); PG8_BAR;
            PG8_LDA(At, 1, 1); PG8_STAGE(PG8_SA(1, 0), a3, voffA);
            PG8_BAR; PG8_WAIT_L(0); PG8_MMA(1, 0, At, B0); PG8_BAR; PG8_SCHED;
            PG8_STAGE(PG8_SB(1, 1), b3 + hstep, voffB);
            PG8_WAIT_V(6); PG8_BAR; PG8_MMA(1, 1, At, B1); PG8_BAR;
            }
        }
        if constexpr (ALIGN_EPI) { if (wr == 0) PG8_BAR; }
        if constexpr (!Epi::AFTER_DRAIN) { E(acc, cur, wr, wc, fr, fq); if (MK_EPI_DRAIN) { PG8_WAIT_V(0); } S.done(cur); }
        if (!has_next) break;
        S.unit_begin(nxt); if constexpr (Epi::HAS_BEGIN) E.begin(nxt);
#pragma unroll
        for (int a = 0; a < 2; ++a)
#pragma unroll
            for (int b = 0; b < 2; ++b)
#pragma unroll
                for (int m = 0; m < 4; ++m)
#pragma unroll
                    for (int n = 0; n < 2; ++n) acc[a][b][m][n] = (f32x4){0.f, 0.f, 0.f, 0.f};
        cur = nxt; cA = nA; cB = nB; cah = nah; ++ui;
        if constexpr (ALIGN_EPI) { if (wr == 1) PG8_BAR; }
    }
    PG8_WAIT_V(0);
    if constexpr (!ALIGN_EPI) { if (wr == 0) PG8_BAR; }
    PG8_BAR;
    if constexpr (Epi::AFTER_DRAIN) { E.fused(acc, cur, wr, wc, fr, fq, lds, wid, lane); S.done(cur); }
#undef PG8_SA
#undef PG8_SB
#undef PG8_STAGE
#undef PG8_LDA
#undef PG8_LDB
#undef PG8_MMA
#undef PG8_WAIT_V
#undef PG8_WAIT_L
#undef PG8_BAR
#undef PG8_SCHED
}
}
#define GAS __attribute__((address_space(1)))
#define LAS __attribute__((address_space(3)))
typedef unsigned short bf16;
typedef unsigned v4u __attribute__((ext_vector_type(4)));
typedef float f32x4 __attribute__((ext_vector_type(4)));
typedef short bf16x8 __attribute__((ext_vector_type(8)));
typedef GAS unsigned gu32;
typedef GAS unsigned long long gu64;
#define RLX_AGENT __ATOMIC_RELAXED, __HIP_MEMORY_SCOPE_AGENT
#define LDS_WAIT() asm volatile("s_waitcnt lgkmcnt(0)" ::: "memory")
#define VM_WAIT() asm volatile("s_waitcnt vmcnt(0)" ::: "memory")
__device__ __forceinline__ unsigned long long rt() { return __builtin_amdgcn_s_memrealtime(); }
__device__ __forceinline__ unsigned f2bf(float f) { unsigned u = __builtin_bit_cast(unsigned, f); return (u + 0x7fffu + ((u >> 16) & 1u)) >> 16; }
__device__ __forceinline__ unsigned pk2(float lo, float hi) { return f2bf(lo) | (f2bf(hi) << 16); }

#define XB_TMO      128
#define XB_XCNT(j)  (256  + 64 * (j))
#define XB_XSUB(j)  (1280 + 64 * (j))
#define XB_XGEN(j)  (2304 + 64 * (j))
#define XB_TOP      3328
#define XB_TOPGEN   3392
#define XCD_BAR_WORDS 3456
#define XB_SPIN_CAP (1u << 18)

__device__ __forceinline__ unsigned xb_ld(unsigned* p)              { return __hip_atomic_load(p, __ATOMIC_RELAXED, __HIP_MEMORY_SCOPE_AGENT); }
__device__ __forceinline__ unsigned xb_add(unsigned* p, unsigned v) { return __hip_atomic_fetch_add(p, v, __ATOMIC_RELAXED, __HIP_MEMORY_SCOPE_AGENT); }
__device__ __forceinline__ unsigned xb_xcc_id() { return (unsigned)__builtin_amdgcn_s_getreg((3 << 11) | 20) & 0xFu; }
#define XB_SPIN(cond, bar) do { unsigned _sp = 0; while (cond) { __builtin_amdgcn_s_sleep(1); \
    if ((++_sp & 255u) == 0u) { if (xb_ld(&(bar)[XB_TMO])) break; if (_sp > XB_SPIN_CAP) { atomicAdd(&(bar)[XB_TMO], 1u); break; } } } } while (0)

struct XcdBarrier {
    unsigned* bar; unsigned x;
    volatile LAS unsigned* st;
};

__device__ __forceinline__ XcdBarrier xcd_barrier_post(unsigned* bar, volatile LAS unsigned* st) {
    XcdBarrier b; b.bar = bar; b.x = xb_xcc_id(); b.st = st;
    if (threadIdx.x == 0) (void)xb_add(&bar[XB_XCNT(b.x)], 1u);
    return b;
}
__device__ __forceinline__ void xcd_barrier_complete(unsigned* bar, unsigned x, unsigned& nloc, unsigned& nx) {
    const unsigned G = gridDim.x * gridDim.y * gridDim.z;
    unsigned sum, cnt, mine, sp = 0u;
    for (;;) {
        sum = 0u; cnt = 0u; mine = 0u;
#pragma unroll
        for (unsigned j = 0; j < 16; ++j) { const unsigned c = xb_ld(&bar[XB_XCNT(j)]); sum += c; cnt += (c > 0u) ? 1u : 0u; mine = (j == x) ? c : mine; }
        if (sum == G) break;
        __builtin_amdgcn_s_sleep(1);
        if ((++sp & 255u) == 0u) { if (xb_ld(&bar[XB_TMO])) break; if (sp > XB_SPIN_CAP) { atomicAdd(&bar[XB_TMO], 1u); break; } }
    }
    nloc = mine > 0u ? mine : 1u; nx = cnt > 0u ? cnt : 1u;
}

__device__ __forceinline__ void xcd_barrier(const XcdBarrier& b) {
    asm volatile("s_waitcnt vmcnt(0)" ::: "memory");
    __syncthreads();
    if (threadIdx.x == 0) {
        unsigned* bar = b.bar;
        __builtin_amdgcn_s_waitcnt(0);
        unsigned nloc = b.st[0], nx = b.st[1];
        if (nloc == 0u) { xcd_barrier_complete(bar, b.x, nloc, nx); b.st[0] = nloc; b.st[1] = nx; }
        const unsigned old = xb_add(&bar[XB_XSUB(b.x)], 1u);
        const unsigned gen = old / nloc;
        if (old + 1u == (gen + 1u) * nloc) {
            __builtin_amdgcn_fence(__ATOMIC_RELEASE, "agent");
            asm volatile("s_waitcnt vmcnt(0)" ::: "memory");
            const unsigned og = xb_add(&bar[XB_TOP], 1u);
            const unsigned tg = og / nx;
            if (og + 1u == (tg + 1u) * nx) xb_add(&bar[XB_TOPGEN], 1u);
            else XB_SPIN(xb_ld(&bar[XB_TOPGEN]) == tg, bar);
            __builtin_amdgcn_fence(__ATOMIC_ACQUIRE, "agent");
            xb_add(&bar[XB_XGEN(b.x)], 1u);
            asm volatile("s_waitcnt vmcnt(0)" ::: "memory");
        } else {
            XB_SPIN(xb_ld(&bar[XB_XGEN(b.x)]) == gen, bar);
            __builtin_amdgcn_fence(__ATOMIC_ACQUIRE, "agent");
            asm volatile("s_waitcnt vmcnt(0)" ::: "memory");
        }
    }
    __syncthreads();
}

__device__ __forceinline__ void xcd_barrier_local(const XcdBarrier& b) {
    asm volatile("s_waitcnt vmcnt(0)" ::: "memory");
    __syncthreads();
    if (threadIdx.x == 0) {
        unsigned* bar = b.bar;
        __builtin_amdgcn_s_waitcnt(0);
        unsigned nloc = b.st[0], nx = b.st[1];
        if (nloc == 0u) { xcd_barrier_complete(bar, b.x, nloc, nx); b.st[0] = nloc; b.st[1] = nx; }
        const unsigned old = xb_add(&bar[XB_XSUB(b.x)], 1u);
        const unsigned gen = old / nloc;
        if (old + 1u == (gen + 1u) * nloc) xb_add(&bar[XB_XGEN(b.x)], 1u);
        else XB_SPIN(xb_ld(&bar[XB_XGEN(b.x)]) == gen, bar);
        __builtin_amdgcn_fence(__ATOMIC_ACQUIRE, "agent");
        asm volatile("s_waitcnt vmcnt(0)" ::: "memory");
    }
    __syncthreads();
}

#ifndef MK_FUSE5
#define MK_FUSE5 1
#endif
#ifndef MK_HALVES
#define MK_HALVES 1
#endif
#ifndef MK_PAQ
#define MK_PAQ 0
#endif
#ifndef MK_EPI3
#define MK_EPI3 1
#endif
#ifndef MK_LIGHT
#define MK_LIGHT 1
#endif
#ifndef MK_CTXB
#define MK_CTXB 1
#endif
#ifndef MK_TQ
#define MK_TQ 1
#endif
#ifndef MK_NANPOISON
#define MK_NANPOISON 0
#endif
#ifndef MK_NOASM
#define MK_NOASM 0
#endif
#ifndef MK_DIAG_RAWY
#define MK_DIAG_RAWY 0
#endif
constexpr int NWAVES = 8;
constexpr int DM = 1024, NCTX = 4096, NLAT = 16384, NTOK = 20480, INW = 1280, DFF = 2816, UPW = 5632;
constexpr float RMS_EPS = 1e-6f;
constexpr float LOG2E = 1.4426950408889634f;
constexpr float QSCALE = 0.125f * LOG2E;
constexpr int NSEG = 160;

constexpr size_t MiB = 1u << 20;
constexpr size_t WS_CTL = 0, CTL_ZERO_BYTES = 1 * MiB;
constexpr size_t WS_MOD = 1 * MiB;
constexpr size_t WS_ROPE = 1 * MiB + 128 * 1024;
constexpr size_t WS_SSMC = 1 * MiB + 256 * 1024;
constexpr size_t WS_SSMG = 2 * MiB + 256 * 1024;
constexpr size_t WS_ESEG = 190 * MiB;
constexpr size_t WS_CTXK = 8 * MiB, WS_CTXVT = 8 * MiB + 512 * 1024;
constexpr size_t WS_SB = 9 * MiB;
constexpr size_t WS_WIN = 16 * MiB, WS_WOUT = 19 * MiB, WS_WUP = 21 * MiB, WS_WDN = 32 * MiB;
constexpr size_t WS_XN = 38 * MiB;
constexpr size_t WS_R = 78 * MiB;
constexpr size_t WS_Q = WS_R, WS_K = WS_R + 20 * MiB, WS_VT = WS_R + 25 * MiB, WS_U = WS_R + 30 * MiB, WS_SS = WS_R + 50 * MiB, WS_AO = 200 * MiB;
constexpr size_t WS_PS = 240 * MiB;
constexpr size_t WS_ACT = WS_R;
constexpr size_t WS_END = 244 * MiB;
constexpr int CW_BAR = 4096, CW_RANK = 65536, CW_TCNT = 98304, CW_PAQ = 131072, CW_TQ = 140000;
constexpr int CW_BAR_ = 0;

constexpr int RING_OFF = 0, RING_BYTES = 131072;
constexpr int LDSCTL_OFF = RING_BYTES, MISC_OFF = LDSCTL_OFF + 320;
constexpr int XBUF_OFF = RING_BYTES + 1024;
constexpr int CWL_OFF = XBUF_OFF + 10240;
constexpr int LDS_BYTES = 147456;

typedef short bf16x4 __attribute__((ext_vector_type(4)));
typedef float f32x16 __attribute__((ext_vector_type(16)));
typedef unsigned u32x2 __attribute__((ext_vector_type(2)));
typedef float f32x2t __attribute__((ext_vector_type(2)));
typedef __bf16 bf16x2t __attribute__((ext_vector_type(2)));
__device__ __forceinline__ unsigned cvtpk(float lo, float hi) { f32x2t v = {lo, hi}; bf16x2t b = __builtin_convertvector(v, bf16x2t); return __builtin_bit_cast(unsigned, b); }
__device__ __forceinline__ float bf2f(unsigned short h) { return __builtin_bit_cast(float, (unsigned)h << 16); }
__device__ __forceinline__ float sum_x16(float v) { const auto r = __builtin_amdgcn_permlane16_swap(__float_as_uint(v), __float_as_uint(v), false, false); return __uint_as_float(r[0]) + __uint_as_float(r[1]); }
__device__ __forceinline__ float sum_x32(float v) { const auto r = __builtin_amdgcn_permlane32_swap(__float_as_uint(v), __float_as_uint(v), false, false); return __uint_as_float(r[0]) + __uint_as_float(r[1]); }
__device__ __forceinline__ float max_x32(float v) { const auto r = __builtin_amdgcn_permlane32_swap(__float_as_uint(v), __float_as_uint(v), false, false); return fmaxf(__uint_as_float(r[0]), __uint_as_float(r[1])); }
__device__ __forceinline__ float wave_sum(float v) {
    v += __int_as_float(__builtin_amdgcn_update_dpp(0, __float_as_int(v), 0xB1, 0xF, 0xF, true));
    v += __int_as_float(__builtin_amdgcn_update_dpp(0, __float_as_int(v), 0x4E, 0xF, 0xF, true));
    v += __int_as_float(__builtin_amdgcn_update_dpp(0, __float_as_int(v), 0x141, 0xF, 0xF, true));
    v += __int_as_float(__builtin_amdgcn_update_dpp(0, __float_as_int(v), 0x140, 0xF, 0xF, true));
    return sum_x32(sum_x16(v));
}
__device__ __forceinline__ float fast_sigmoid(float x) { return __builtin_amdgcn_rcpf(1.f + __builtin_amdgcn_exp2f(-x * LOG2E)); }
__device__ __forceinline__ float siluf(float x) { return x * fast_sigmoid(x); }
__device__ __forceinline__ float gelu_tanh(float x) { const float u = 0.7978845608028654f * (x + 0.044715f * x * x * x); return x * fast_sigmoid(2.f * u); }

struct Args {
    const float *x_prompt, *x_sample, *cache_k, *cache_v, *st_re, *st_im, *c, *c_ctx, *w_ada, *b_ada, *g_norm1, *g_norm2, *w_in, *sink;
    const float *lam_re, *lam_im, *log_dt, *b_re, *b_im, *c_re, *c_im, *ssm_d, *wglu, *g_attn, *g_ssm, *w_out, *w_up, *conv_w, *conv_b, *w_down, *g_final;
    float* out; unsigned char* ws; int ph_lo, ph_hi, li, pad;
};

struct Frame {
    LAS unsigned char* lds; volatile LAS unsigned* MISC; gu32* ctl;
    int tid, lane, wave, G;
    int xo, nx, rank, nloc;
};
template <bool HV> struct XcdOrderT {
    static constexpr bool HALVES = HV;
    int nN, npm, nx, xo, rank, nloc, mmajor; unsigned* cnt; const float* ps; LAS float* rs; int R, lo; bool hs; int rot, cpn;
    __device__ __forceinline__ void init(int M, int N, const Frame& F, int mmajor_ = 0, unsigned* cnt_ = nullptr) { nN = N / 256; nx = F.nx; xo = F.xo; rank = F.rank; nloc = F.nloc; mmajor = mmajor_; cnt = cnt_; ps = nullptr; rs = nullptr; rot = 0; cpn = 0; const int nM = M / 256; npm = xo < nM ? (nM - xo + nx - 1) / nx : 0;
        const int tot = npm * nN; R = tot / nloc; lo = tot - R * nloc; hs = HV && lo > 0 && 2 * lo <= nloc; }
    __device__ __forceinline__ bool next(int i, pg8::Unit& u) const { int j = i * nloc + rank; u.hm = -1;
        if (hs && i >= R) { if (i > R || rank >= 2 * lo) return false; j = R * nloc + (rank >> 1); u.hm = rank & 1; }
        else if (j >= npm * nN) return false;
        if (mmajor) { u.pm = xo + nx * (j / nN); u.pn = j % nN; } else { u.pm = xo + nx * (j % npm); u.pn = j / npm + rot; if (u.pn >= nN) u.pn -= nN; } return true; }
    __device__ __forceinline__ void a_ready(const pg8::Unit&) const {}
    __device__ __forceinline__ void unit_begin(const pg8::Unit& u) const {
        if (ps) { const int t = threadIdx.x; const f32x4* p = (const f32x4*)(ps + ((size_t)(u.pm * 256 + (t >> 1))) * 32 + 16 * (t & 1));
            const f32x4 a0 = p[0], a1 = p[1], a2 = p[2], a3 = p[3];
            float sq = ((a0.x + a0.y) + (a0.z + a0.w)) + ((a1.x + a1.y) + (a1.z + a1.w)) + (((a2.x + a2.y) + (a2.z + a2.w)) + ((a3.x + a3.y) + (a3.z + a3.w)));
            sq += __int_as_float(__builtin_amdgcn_update_dpp(0, __float_as_int(sq), 0xB1, 0xF, 0xF, true));
            if (!(t & 1)) rs[t >> 1] = rsqrtf(sq * (1.f / 512.f) + RMS_EPS); }
    }
    __device__ __forceinline__ void done(const pg8::Unit& u) const {
        if (cnt && u.pn >= cpn) { asm volatile("s_waitcnt vmcnt(0) lgkmcnt(0)" ::: "memory"); __builtin_amdgcn_s_barrier(); asm volatile("" ::: "memory");
            if (threadIdx.x == 0) __hip_atomic_fetch_add(cnt + 64 * u.pm, u.hm < 0 ? 2u : 1u, __ATOMIC_RELAXED, __HIP_MEMORY_SCOPE_AGENT); }
    }
};
typedef XcdOrderT<false> XcdOrder;
__device__ __forceinline__ void tiles_wait(Frame& F, unsigned* cnt, int lt0, int lt1, unsigned need) {
    if (F.tid == 0) {
        unsigned sp = 0;
        for (int lt = lt0; lt < lt1; ++lt) { const int pm = F.xo + F.nx * lt;
            while (__hip_atomic_load(cnt + 64 * pm, __ATOMIC_RELAXED, __HIP_MEMORY_SCOPE_AGENT) < need) { __builtin_amdgcn_s_sleep(8); if (++sp > (1u << 22)) { __hip_atomic_store((unsigned*)F.ctl + 2, 0xDEADu, __ATOMIC_RELAXED, __HIP_MEMORY_SCOPE_AGENT); break; } } }
        __builtin_amdgcn_fence(__ATOMIC_ACQUIRE, "agent");
        asm volatile("s_waitcnt vmcnt(0)" ::: "memory");
    }
    __syncthreads();
}
#define ROWS_AFFINE_BEGIN(F, row, cnt, nN_, HS_) { const int npm_ = (F).xo < 80 ? (80 - (F).xo + (F).nx - 1) / (F).nx : 0; \
    const int tot_ = npm_ * (nN_), lo0_ = tot_ % (F).nloc, lo_ = (cnt) ? (((HS_) && lo0_ > 0 && 2 * lo0_ <= (F).nloc) ? 2 * lo0_ : lo0_) : 0, ne_ = (cnt) ? ((tot_ / (F).nloc) * (F).nloc) / (nN_) : npm_; \
    const bool part_ = !(cnt) || lo_ == 0 || (F).nloc - lo_ < 4; const int w0_ = part_ ? 0 : lo_, nw_ = (F).nloc - w0_; \
    if ((F).rank >= w0_) for (int grp_ = 0; grp_ < 2; ++grp_) { const int lt0_ = grp_ ? ne_ : 0, lt1_ = grp_ ? npm_ : ne_; if (lt0_ >= lt1_) continue; \
        if (cnt) tiles_wait(F, cnt, lt0_, lt1_, (unsigned)(2 * (nN_))); \
        for (int lt_ = lt0_; lt_ < lt1_; ++lt_) for (int r_ = ((F).rank - w0_) * NWAVES + (F).wave; r_ < 256; r_ += 2 * nw_ * NWAVES) { const int row = ((F).xo + (F).nx * lt_) * 256 + r_; \
            const bool has2 = r_ + nw_ * NWAVES < 256; const int row2 = has2 ? row + nw_ * NWAVES : row;
#define ROWS_AFFINE_END } } }

__device__ __forceinline__ void transpose_item(const float* W, int K, int N, bf16* WT, int k0, int n0, int dst_row0, LAS float* scr, int lane, int kdst = -1, const float* ksc = nullptr) {
    if (kdst < 0) kdst = k0;
    LAS unsigned* s32 = (LAS unsigned*)scr;
    const int r = lane >> 3, c4 = lane & 7;
    const float* wp = W + (size_t)(k0 + 2 * r) * N + n0 + 4 * c4;
    f32x4 v[4][2];
#pragma unroll
    for (int i = 0; i < 4; ++i) { v[i][0] = *(const f32x4*)(wp + (size_t)(16 * i) * N); v[i][1] = *(const f32x4*)(wp + (size_t)(16 * i + 1) * N); }
    if (ksc) {
#pragma unroll
        for (int i = 0; i < 4; ++i) { v[i][0] = v[i][0] * ksc[16 * i + 2 * r]; v[i][1] = v[i][1] * ksc[16 * i + 2 * r + 1]; } }
#pragma unroll
    for (int i = 0; i < 4; ++i) { LAS unsigned* d = s32 + (4 * c4) * 33 + 8 * i + r;
        d[0 * 33] = pk2(v[i][0].x, v[i][1].x); d[1 * 33] = pk2(v[i][0].y, v[i][1].y); d[2 * 33] = pk2(v[i][0].z, v[i][1].z); d[3 * 33] = pk2(v[i][0].w, v[i][1].w); }
    LDS_WAIT(); asm volatile("" ::: "memory");
    const int c = lane & 7;
#pragma unroll
    for (int j = 0; j < 4; ++j) { const int n = (lane >> 3) + 8 * j; const LAS unsigned* s = s32 + n * 33 + 4 * c;
        v4u o; o.x = s[0]; o.y = s[1]; o.z = s[2]; o.w = s[3];
        *(GAS v4u*)(WT + (size_t)(dst_row0 + n) * K + kdst + 8 * c) = o; }
    LDS_WAIT(); asm volatile("" ::: "memory");
}

__device__ __forceinline__ void wout_item(const Args& a, int r, LAS float* scr, int lane) {
    const int kb = r / 32, nb = r % 32;
    if (MK_FUSE5) transpose_item(a.w_out, 1024, 1024, (bf16*)(a.ws + WS_WOUT), 64 * kb, 32 * nb, 32 * nb, scr, lane, (64 * kb + 512) & 1023, kb >= 8 ? a.g_ssm + 64 * (kb - 8) : nullptr);
    else transpose_item(a.w_out, 1024, 1024, (bf16*)(a.ws + WS_WOUT), 64 * kb, 32 * nb, 32 * nb, scr, lane);
}
__device__ __forceinline__ void updn_item(const Args& a, int r, LAS float* scr, int lane) {
    unsigned char* ws = a.ws;
    if (r < 16 * 32) { wout_item(a, r, scr, lane); return; }
    r -= 16 * 32;
    if (r < 16 * 176) { const int kb = r / 176, nb = r % 176; const int n0 = 32 * nb; const int half = n0 >= DFF ? 1 : 0; const int f = n0 - half * DFF;
        transpose_item(a.w_up, 1024, UPW, (bf16*)(ws + WS_WUP), 64 * kb, n0, 256 * (f >> 7) + 128 * half + (f & 127), scr, lane); return; }
    r -= 16 * 176;
    { const int kb = r / 32, nb = r % 32; transpose_item(a.w_down, DFF, 1024, (bf16*)(ws + WS_WDN), 64 * kb, 32 * nb, 32 * nb, scr, lane); }
}
__device__ __forceinline__ void transpose_queue(Frame& F, const Args& a) {
    constexpr int NQ = 16 * 32 + 16 * 176 + 44 * 32;
    unsigned* head = (unsigned*)F.ctl + CW_TQ;
    volatile LAS unsigned* slot = F.MISC + 44;
    LAS float* scr = (LAS float*)(F.lds + RING_OFF + F.wave * 16384);
    unsigned kn = 0;
    if (F.tid == 0) kn = __hip_atomic_fetch_add(head, 8u, __ATOMIC_RELAXED, __HIP_MEMORY_SCOPE_AGENT);
    for (int it = 0; ; ++it) {
        if (F.tid == 0) { slot[it & 1] = kn; kn = __hip_atomic_fetch_add(head, 8u, __ATOMIC_RELAXED, __HIP_MEMORY_SCOPE_AGENT); }
        __syncthreads();
        const unsigned k0 = slot[it & 1];
        if (k0 >= (unsigned)NQ) break;
        const unsigned k = k0 + (unsigned)F.wave;
        if (k < (unsigned)NQ) updn_item(a, (int)k, scr, F.lane);
    }
}

constexpr int ADA_UNITS = 192;
__device__ __forceinline__ void p0_setup(Frame& F, const Args& a) {
    unsigned char* ws = a.ws;
    float* MOD = (float*)(ws + WS_MOD);
    LAS float* ldsf = (LAS float*)F.lds;
    for (int u = blockIdx.x; u < ADA_UNITS; u += F.G) {
        LAS float* scond = ldsf; LAS float* red = ldsf + 5120;
        for (int i = F.tid; i < 5120; i += 512) { const int r = i >> 10, k = i & 1023; const float v = (r == 0) ? a.c_ctx[k] : a.c[(r - 1) * 1024 + k]; scond[i] = v / (1.f + __expf(-v)); }
        __syncthreads();
        const int n0 = u * 32, rg = F.lane >> 3, c4 = F.lane & 7;
        float acc[5][4];
#pragma unroll
        for (int r = 0; r < 5; ++r)
#pragma unroll
            for (int j = 0; j < 4; ++j) acc[r][j] = 0.f;
        const float* wp = a.w_ada + (size_t)(F.wave * 128 + rg) * 6144 + n0 + 4 * c4;
#pragma unroll 8
        for (int i = 0; i < 16; ++i) {
            const f32x4 w = *(const f32x4*)(wp + (size_t)i * 8 * 6144);
            const int k = F.wave * 128 + 8 * i + rg;
#pragma unroll
            for (int r = 0; r < 5; ++r) { const float s = scond[r * 1024 + k]; acc[r][0] += s * w.x; acc[r][1] += s * w.y; acc[r][2] += s * w.z; acc[r][3] += s * w.w; }
        }
#pragma unroll
        for (int r = 0; r < 5; ++r)
#pragma unroll
            for (int j = 0; j < 4; ++j) { float v = acc[r][j]; v += __int_as_float(__builtin_amdgcn_update_dpp(0, __float_as_int(v), 0x128, 0xF, 0xF, true));
                acc[r][j] = sum_x32(sum_x16(v)); }
        if (rg == 0) {
#pragma unroll
            for (int r = 0; r < 5; ++r)
#pragma unroll
                for (int j = 0; j < 4; ++j) red[(F.wave * 5 + r) * 32 + 4 * c4 + j] = acc[r][j];
        }
        __syncthreads();
        if (F.tid < 160) { const int r = F.tid >> 5, cc = F.tid & 31; float s = a.b_ada[n0 + cc];
#pragma unroll
            for (int w = 0; w < 8; ++w) s += red[(w * 5 + r) * 32 + cc];
            MOD[r * 6144 + n0 + cc] = s; }
        __syncthreads();
    }
    __syncthreads();
    {
        LAS float* scr = (LAS float*)(F.lds + RING_OFF + F.wave * 16384);
        const int gw = (int)blockIdx.x * NWAVES + F.wave, NGW = F.G * NWAVES;
        constexpr int I_IN = 16 * 40, I_OUT = 16 * 32, I_UP = 16 * 176, I_DN = 44 * 32;
        constexpr int NITEMS = MK_TQ ? I_IN : I_IN + I_OUT + I_UP + I_DN;
        const int npoor = F.G > ADA_UNITS ? ADA_UNITS * NWAVES : 0, nrich = NGW - npoor;
        const bool rich = gw >= npoor; const int wi = rich ? gw - npoor : gw;
        const int rich_items = nrich * 3 < NITEMS ? nrich * 3 : NITEMS;
        const int nbase = rich ? 3 : 2, poor_end = rich_items + 2 * npoor < NITEMS ? rich_items + 2 * npoor : NITEMS;
        for (int q = 0; ; ++q) {
            int it;
            if (q < nbase) { it = rich ? wi + q * nrich : rich_items + wi + q * npoor; if (it >= (rich ? rich_items : poor_end)) continue; }
            else { it = poor_end + (q - nbase) * NGW + gw; if (it >= NITEMS) break; }
            int r = it;
            if (r < I_IN) { const int kb = r / 40, nb = r % 40; transpose_item(a.w_in, 1024, 1280, (bf16*)(ws + WS_WIN), 64 * kb, 32 * nb, 32 * nb, scr, F.lane); continue; } r -= I_IN;
            if (!MK_TQ) { if (r < I_OUT) { wout_item(a, r, scr, F.lane); continue; } r -= I_OUT; }
            if (r < I_UP) { const int kb = r / 176, nb = r % 176; const int n0 = 32 * nb; const int half = n0 >= DFF ? 1 : 0; const int f = n0 - half * DFF;
                transpose_item(a.w_up, 1024, UPW, (bf16*)(ws + WS_WUP), 64 * kb, n0, 256 * (f >> 7) + 128 * half + (f & 127), scr, F.lane); continue; } r -= I_UP;
            { const int kb = r / 32, nb = r % 32; transpose_item(a.w_down, DFF, 1024, (bf16*)(ws + WS_WDN), 64 * kb, 32 * nb, 32 * nb, scr, F.lane); }
        }
    }
    {
        const int gt = ((int)blockIdx.x * NWAVES + F.wave) * 64 + F.lane, NGT = F.G * NWAVES * 64;
        float* RC = (float*)(ws + WS_ROPE); float* RS = RC + 1024;
        for (int i = gt; i < 1024; i += NGT) { const int pos = i >> 4, fi = i & 15; const float ang = (float)pos * powf(10000.f, -(float)fi / 16.f); RC[i] = cosf(ang); RS[i] = sinf(ang); }
        bf16* CK = (bf16*)(ws + WS_CTXK); bf16* CVT = (bf16*)(ws + WS_CTXVT);
        for (int i = gt; i < 4 * 512 * 128; i += NGT) {
            CK[i] = (bf16)f2bf(a.cache_k[i]);
            const int t = i & 511, d = (i >> 9) & 63, kvh = (i >> 15) & 1, b = i >> 16;
            CVT[i] = (bf16)f2bf(a.cache_v[((size_t)(b * 512 + t) * 2 + kvh) * 64 + d]);
        }
        const int gw = (int)blockIdx.x * NWAVES + F.wave, NGW = F.G * NWAVES;
        const int task = gw - (NGW - 64);
        if (task >= 0) {
            const int gi = task, g = gi & 31, n = F.lane;
            const float lr = a.lam_re[gi * 64 + n], li = a.lam_im[gi * 64 + n], dt = expf(a.log_dt[gi]);
            const float mag = expf(lr * dt), ang = li * dt, a_re = mag * cosf(ang), a_im = mag * sinf(ang);
            const float den = lr * lr + li * li, nr = a_re - 1.f;
            const float cf_re = (nr * lr + a_im * li) / den, cf_im = (a_im * lr - nr * li) / den;
            unsigned char* base = ws + WS_SSMC + (size_t)gi * 16384;
            bf16* BBm = (bf16*)base; bf16* CM = (bf16*)(base + 4096); float* AP = (float*)(base + 8192);
            const int c = n & 31, hi = n >> 5;
            for (int p = 0; p < 16; ++p) {
                const float br = a.b_re[(size_t)(gi * 64 + n) * 16 + p], bi = a.b_im[(size_t)(gi * 64 + n) * 16 + p];
                BBm[((2 * hi) * 32 + c) * 16 + p] = (bf16)f2bf(cf_re * br - cf_im * bi);
                BBm[((2 * hi + 1) * 32 + c) * 16 + p] = (bf16)f2bf(cf_re * bi + cf_im * br);
                CM[p * 128 + 4 * c + 2 * hi] = (bf16)f2bf(a.c_re[(size_t)(gi * 16 + p) * 64 + n]);
                CM[p * 128 + 4 * c + 2 * hi + 1] = (bf16)f2bf(-a.c_im[(size_t)(gi * 16 + p) * 64 + n]);
            }
            AP[n] = a_re; AP[64 + n] = a_im;
            { const float m64 = expf(lr * dt * 64.f), g64 = li * dt * 64.f; AP[128 + n] = m64 * cosf(g64); AP[192 + n] = m64 * sinf(g64); }
            { const float m128 = expf(lr * dt * 128.f), g128 = li * dt * 128.f; AP[256 + n] = m128 * cosf(g128); AP[320 + n] = m128 * sinf(g128); }
            if (gi < 32) {
                unsigned char* gb = ws + WS_SSMG + (size_t)g * 1024; bf16* WgT = (bf16*)gb; float* dd = (float*)(gb + 512);
                for (int e = n; e < 256; e += 64) { const int q = e >> 4, p = e & 15; WgT[q * 16 + p] = (bf16)f2bf(a.wglu[(g * 16 + p) * 16 + q]); }
                if (n < 16) dd[n] = a.ssm_d[g * 16 + n];
            }
        }
    }
}

__device__ __forceinline__ int row_cls(int row) { return row < NCTX ? 0 : 1 + ((row - NCTX) >> 12); }
__device__ __forceinline__ void p_modulate(Frame& F, const Args& a, int which, unsigned* cnt = nullptr) {
    const float* MOD = (const float*)(a.ws + WS_MOD);
    const float* gn = which ? a.g_norm2 : a.g_norm1;
    const int sh_off = which ? 3072 : 0, sc_off = which ? 4096 : 1024;
    bf16* XN = (bf16*)(a.ws + WS_XN);
    ROWS_AFFINE_BEGIN(F, row, cnt, 4, 0) {
        int rw[2] = {row, row2};
        f32x4 v[2][4]; float s[2] = {0.f, 0.f};
#pragma unroll
        for (int q = 0; q < 2; ++q) { const int rr = rw[q];
            const float* xr = which ? a.out + (size_t)rr * DM : (rr < NCTX ? a.x_prompt + (size_t)rr * DM : a.x_sample + (size_t)(rr - NCTX) * DM);
#pragma unroll
            for (int j = 0; j < 4; ++j) v[q][j] = *(const f32x4*)(xr + 4 * F.lane + 256 * j); }
#pragma unroll
        for (int q = 0; q < 2; ++q)
#pragma unroll
            for (int j = 0; j < 4; ++j) s[q] += (v[q][j].x * v[q][j].x + v[q][j].y * v[q][j].y) + (v[q][j].z * v[q][j].z + v[q][j].w * v[q][j].w);
        const int cls = row_cls(row);
#pragma unroll
        for (int q = 0; q < 2; ++q) { if (q == 1 && !has2) break;
            const float rstd = rsqrtf(wave_sum(s[q]) * (1.f / DM) + RMS_EPS);
#pragma unroll
            for (int j = 0; j < 4; ++j) { const int c = 4 * F.lane + 256 * j;
                const f32x4 g = *(const f32x4*)(gn + c), sc = *(const f32x4*)(MOD + cls * 6144 + sc_off + c), sh = *(const f32x4*)(MOD + cls * 6144 + sh_off + c);
                const f32x4 o = v[q][j] * rstd * g * (sc + 1.f) + sh;
                u32x2 w; w.x = cvtpk(o.x, o.y); w.y = cvtpk(o.z, o.w);
                *(u32x2*)(XN + (size_t)rw[q] * DM + c) = w; } }
    } ROWS_AFFINE_END
}

struct EpiInProj {
    static constexpr bool PERM = false, AFTER_DRAIN = false, HAS_BEGIN = false; static constexpr int MID = 0;
    bf16 *Q, *Kb, *VT, *U; float *ok, *ov; const float *RC, *RS;
    __device__ __forceinline__ void operator()(const f32x4 (&acc)[2][2][4][2], const pg8::Unit& u, int wr, int wc, int fr, int fq) const {
        const int rowt = u.pm * 256; const bool latent = rowt >= NCTX; const int half = wc & 1;
#pragma unroll
        for (int ai = 0; ai < 2; ++ai)
#pragma unroll
            for (int m = 0; m < 4; ++m) {
                const int row = rowt + ai * 128 + wr * 64 + m * 16 + fr;
                f32x4 cs = {1.f, 1.f, 1.f, 1.f}, sn = {0.f, 0.f, 0.f, 0.f};
                if (latent && u.pn <= 2) { const int t = (row - NCTX) & 4095; const int pos = half ? (t & 63) : (t >> 6); cs = *(const f32x4*)(RC + pos * 16 + 4 * fq); sn = *(const f32x4*)(RS + pos * 16 + 4 * fq); }
#pragma unroll
                for (int bj = 0; bj < 2; ++bj) {
                    const f32x4 v0 = acc[ai][bj][m][0], v1 = acc[ai][bj][m][1];
                    if (u.pn < 2) {
                        const f32x4 r0 = (v0 * cs - v1 * sn) * QSCALE, r1 = (v0 * sn + v1 * cs) * QSCALE;
                        bf16* p = Q + (size_t)row * 512 + u.pn * 256 + bj * 128 + wc * 32 + 4 * fq;
                        u32x2 w0, w1; w0.x = cvtpk(r0.x, r0.y); w0.y = cvtpk(r0.z, r0.w); w1.x = cvtpk(r1.x, r1.y); w1.y = cvtpk(r1.z, r1.w);
                        *(u32x2*)p = w0; *(u32x2*)(p + 16) = w1;
                    } else if (u.pn == 2) {
                        if (bj == 0) {
                            const f32x4 r0 = v0 * cs - v1 * sn, r1 = v0 * sn + v1 * cs;
                            const int col = wc * 32 + 4 * fq;
                            bf16* p = Kb + (size_t)row * 128 + col;
                            u32x2 w0, w1; w0.x = cvtpk(r0.x, r0.y); w0.y = cvtpk(r0.z, r0.w); w1.x = cvtpk(r1.x, r1.y); w1.y = cvtpk(r1.z, r1.w);
                            *(u32x2*)p = w0; *(u32x2*)(p + 16) = w1;
                            if (!latent) { *(f32x4*)(ok + (size_t)row * 128 + col) = v0; *(f32x4*)(ok + (size_t)row * 128 + col + 16) = v1; }
                        } else {
                            const int col = wc * 32 + 4 * fq;
                            bf16* p = VT + (size_t)col * NTOK + row;
                            p[0 * NTOK] = (bf16)f2bf(v0.x); p[1 * NTOK] = (bf16)f2bf(v0.y); p[2 * NTOK] = (bf16)f2bf(v0.z); p[3 * NTOK] = (bf16)f2bf(v0.w);
                            p[16 * NTOK] = (bf16)f2bf(v1.x); p[17 * NTOK] = (bf16)f2bf(v1.y); p[18 * NTOK] = (bf16)f2bf(v1.z); p[19 * NTOK] = (bf16)f2bf(v1.w);
                            if (!latent) { *(f32x4*)(ov + (size_t)row * 128 + col) = v0; *(f32x4*)(ov + (size_t)row * 128 + col + 16) = v1; }
                        }
                    } else {
                        bf16* p = U + (size_t)row * 512 + (u.pn - 3) * 256 + bj * 128 + wc * 32 + 4 * fq;
                        u32x2 w0, w1; w0.x = cvtpk(v0.x, v0.y); w0.y = cvtpk(v0.z, v0.w); w1.x = cvtpk(v1.x, v1.y); w1.y = cvtpk(v1.z, v1.w);
                        *(u32x2*)p = w0; *(u32x2*)(p + 16) = w1;
                    }
                }
            }
    }
};

template <bool IN_PLACE> struct EpiResid {
    static constexpr bool PERM = false, AFTER_DRAIN = false, HAS_BEGIN = false; static constexpr int MID = (!IN_PLACE && MK_FUSE5) ? 8 : 0;
    const float *xp, *xs, *MOD; float* out; int gate_off; LAS float* rs = nullptr;
    __device__ __forceinline__ void mid(f32x4 (&acc)[2][2][4][2], int wr, int fr) const {
#pragma unroll
        for (int ai = 0; ai < 2; ++ai)
#pragma unroll
            for (int m = 0; m < 4; ++m) { const float sc = rs[ai * 128 + wr * 64 + m * 16 + fr];
#pragma unroll
                for (int bj = 0; bj < 2; ++bj)
#pragma unroll
                    for (int n = 0; n < 2; ++n) acc[ai][bj][m][n] = acc[ai][bj][m][n] * sc; }
    }
    __device__ __forceinline__ void operator()(const f32x4 (&acc)[2][2][4][2], const pg8::Unit& u, int wr, int wc, int fr, int fq) const {
        const int rowt = u.pm * 256 + (u.hm > 0 ? 128 : 0); const int cls = row_cls(rowt); const int nai = u.hm >= 0 ? 1 : 2;
        const float* gp = MOD + cls * 6144 + gate_off + u.pn * 256 + wc * 32 + 4 * fq;
        f32x4 gt[2][2];
#pragma unroll
        for (int bj = 0; bj < 2; ++bj)
#pragma unroll
            for (int n = 0; n < 2; ++n) gt[bj][n] = *(const f32x4*)(gp + bj * 128 + n * 16);
#pragma unroll
        for (int ai = 0; ai < 2; ++ai) { if (ai >= nai) break;
#pragma unroll
            for (int m = 0; m < 4; ++m) {
                const int row = rowt + ai * 128 + wr * 64 + m * 16 + fr;
                const size_t off = (size_t)row * DM + u.pn * 256 + wc * 32 + 4 * fq;
                const float* xin = IN_PLACE ? out + off : (row < NCTX ? xp + off : xs + (off - (size_t)NCTX * DM));
#pragma unroll
                for (int bj = 0; bj < 2; ++bj)
#pragma unroll
                    for (int n = 0; n < 2; ++n) { const f32x4 xv = *(const f32x4*)(xin + bj * 128 + n * 16); *(f32x4*)(out + off + bj * 128 + n * 16) = xv + gt[bj][n] * acc[ai][bj][m][n]; }
            } }
    }
};

__device__ __forceinline__ float fmac_shr1(float acc, float x, float w) { asm("v_fmac_f32_dpp %0, %1, %2 row_shr:1 row_mask:0xf bank_mask:0xf bound_ctrl:1" : "+v"(acc) : "v"(x), "v"(w)); return acc; }
__device__ __forceinline__ float fmac_shl1(float acc, float x, float w) { asm("v_fmac_f32_dpp %0, %1, %2 row_shl:1 row_mask:0xf bank_mask:0xf bound_ctrl:1" : "+v"(acc) : "v"(x), "v"(w)); return acc; }
__device__ __forceinline__ float fmac_ror1(float acc, float x, float w) { asm("v_fmac_f32_dpp %0, %1, %2 row_ror:1 row_mask:0xf bank_mask:0xf" : "+v"(acc) : "v"(x), "v"(w)); return acc; }
__device__ __forceinline__ float fmac_ror15(float acc, float x, float w) { asm("v_fmac_f32_dpp %0, %1, %2 row_ror:15 row_mask:0xf bank_mask:0xf" : "+v"(acc) : "v"(x), "v"(w)); return acc; }
struct EpiUpConv {
    static constexpr bool PERM = false, AFTER_DRAIN = false, HAS_BEGIN = MK_EPI3 != 0; static constexpr int MID = 0;
    bf16* ACT; float* SB; const float *cw, *cb; LAS float* xb; LAS float* cwl;
    __device__ __forceinline__ void begin(const pg8::Unit& u) const {
#pragma unroll
        for (int i = 0; i < 2; ++i) { const int idx = (int)threadIdx.x + 512 * i, prm = idx >> 8, col = idx & 255, bj = col >> 7, wi = bj * DFF + u.pn * 128 + (col & 127);
            const float v = prm < 3 ? cw[prm * UPW + wi] : cb[wi];
            cwl[idx] = v * (bj ? -0.6931471805599453f : -1.4426950408889634f); }
    }
    __device__ __forceinline__ void operator()(const f32x4 (&acc)[2][2][4][2], const pg8::Unit& u, int wr, int wc, int fr, int fq) const {
        const int lane = fr + 16 * fq;
        LAS float* xl = xb + (2 * wr) * 256 + wc * 32 + 4 * fq;
#pragma unroll
        for (int ai = 0; ai < 2; ++ai) { const int sp = 2 * ai + wr;
#pragma unroll
            for (int bj = 0; bj < 2; ++bj)
#pragma unroll
                for (int n = 0; n < 2; ++n) { const int tc = bj * 128 + wc * 32 + n * 16 + 4 * fq;
                    if (fr == 0) *(LAS f32x4*)(xl + (1 + 4 * ai) * 256 + bj * 128 + n * 16) = acc[ai][bj][0][n];
                    if (fr == 15) *(LAS f32x4*)(xl + (2 + 4 * ai) * 256 + bj * 128 + n * 16) = acc[ai][bj][3][n];
                    float* sb = SB + ((size_t)(u.pm * 22 + u.pn) * 4) * 256 + tc;
                    if (sp == 0 && fr < 2) *(f32x4*)(sb + fr * 256) = acc[ai][bj][0][n];
                    if (sp == 3 && fr >= 14) *(f32x4*)(sb + (fr - 12) * 256) = acc[ai][bj][3][n];
                } }
        asm volatile("s_waitcnt lgkmcnt(0)" ::: "memory"); __builtin_amdgcn_s_barrier(); asm volatile("" ::: "memory");
        const int f0 = u.pn * 128 + wc * 32 + 4 * fq;
#if MK_EPI3
#pragma unroll
        for (int ai = 0; ai < 2; ++ai) { const int sp = 2 * ai + wr;
#pragma unroll
            for (int n = 0; n < 2; ++n) {
                f32x4 sg[4];
#pragma unroll
                for (int bj = 0; bj < 2; ++bj) { const int tc = bj * 128 + wc * 32 + n * 16 + 4 * fq;
                    const f32x4 w0 = *(const LAS f32x4*)(cwl + tc), w1 = *(const LAS f32x4*)(cwl + 256 + tc), w2 = *(const LAS f32x4*)(cwl + 512 + tc), bb = *(const LAS f32x4*)(cwl + 768 + tc);
                    const f32x4 z4 = {0.f, 0.f, 0.f, 0.f};
                    const f32x4 w0e = fr == 0 ? w0 : z4, w2e = fr == 15 ? w2 : z4;
                    f32x4 pv = z4, nv = z4;
                    if (sp > 0) pv = *(const LAS f32x4*)(xl + (4 * ai) * 256 + bj * 128 + n * 16);
                    if (sp < 3) nv = *(const LAS f32x4*)(xl + (3 + 4 * ai) * 256 + bj * 128 + n * 16);
#pragma unroll
                    for (int m = 0; m < 4; ++m) { f32x4 rs;
#pragma unroll
                        for (int j = 0; j < 4; ++j) { const float cur = acc[ai][bj][m][n][j];
                            float r = fmaf(w1[j], cur, bb[j]);
                            r = fmac_shr1(r, cur, w0[j]); r = fmac_shl1(r, cur, w2[j]);
                            r = (m > 0) ? fmac_ror1(r, acc[ai][bj][m > 0 ? m - 1 : 0][n][j], w0e[j]) : fmaf(pv[j], w0e[j], r);
                            r = (m < 3) ? fmac_ror15(r, acc[ai][bj][m < 3 ? m + 1 : 3][n][j], w2e[j]) : fmaf(nv[j], w2e[j], r);
                            rs[j] = r; }
                        if (bj == 0) {
#pragma unroll
                            for (int j = 0; j < 4; ++j) sg[m][j] = rs[j] * __builtin_amdgcn_rcpf(1.f + __builtin_amdgcn_exp2f(rs[j]));
                        } else { const int row = u.pm * 256 + ai * 128 + wr * 64 + m * 16 + fr;
                            u32x2 w; w.x = cvtpk(sg[m].x * rs.x, sg[m].y * rs.y); w.y = cvtpk(sg[m].z * rs.z, sg[m].w * rs.w);
                            const bool edge = (u.pm >= 16) && ((sp == 0 && m == 0 && fr == 0) || (sp == 3 && m == 3 && fr == 15));
                            if (!edge) *(u32x2*)(ACT + (size_t)row * DFF + f0 + n * 16) = w; }
                    }
                    __builtin_amdgcn_sched_barrier(0);
                }
            } }
#else
#pragma unroll
        for (int ai = 0; ai < 2; ++ai) { const int sp = 2 * ai + wr;
#pragma unroll
            for (int n = 0; n < 2; ++n) {
                f32x4 sg[4];
#pragma unroll
                for (int bj = 0; bj < 2; ++bj) { const int tc = bj * 128 + wc * 32 + n * 16 + 4 * fq; const int wi = bj * DFF + f0 + n * 16;
                    const f32x4 w0 = *(const f32x4*)(cw + wi), w1 = *(const f32x4*)(cw + UPW + wi), w2 = *(const f32x4*)(cw + 2 * UPW + wi), bb = *(const f32x4*)(cb + wi);
                    f32x4 pv = {0.f, 0.f, 0.f, 0.f}, nv = {0.f, 0.f, 0.f, 0.f};
                    if (sp > 0) pv = *(const LAS f32x4*)(xl + (4 * ai) * 256 + bj * 128 + n * 16);
                    if (sp < 3) nv = *(const LAS f32x4*)(xl + (3 + 4 * ai) * 256 + bj * 128 + n * 16);
#pragma unroll
                    for (int m = 0; m < 4; ++m) { const f32x4 cur = acc[ai][bj][m][n]; f32x4 up, dn;
#pragma unroll
                        for (int j = 0; j < 4; ++j) {
                            const int fu = (m > 0) ? __builtin_amdgcn_update_dpp(0, __float_as_int(acc[ai][bj][m > 0 ? m - 1 : 0][n][j]), 0x121, 0xF, 0xF, false) : __float_as_int(pv[j]);
                            up[j] = __int_as_float(__builtin_amdgcn_update_dpp(fu, __float_as_int(cur[j]), 0x111, 0xF, 0xF, false));
                            const int fd = (m < 3) ? __builtin_amdgcn_update_dpp(0, __float_as_int(acc[ai][bj][m < 3 ? m + 1 : 3][n][j]), 0x12F, 0xF, 0xF, false) : __float_as_int(nv[j]);
                            dn[j] = __int_as_float(__builtin_amdgcn_update_dpp(fd, __float_as_int(cur[j]), 0x101, 0xF, 0xF, false));
                        }
                        const f32x4 rs = w0 * up + w1 * cur + w2 * dn + bb;
                        if (bj == 0) { sg[m].x = siluf(rs.x); sg[m].y = siluf(rs.y); sg[m].z = siluf(rs.z); sg[m].w = siluf(rs.w); }
                        else { const int row = u.pm * 256 + ai * 128 + wr * 64 + m * 16 + fr;
                            u32x2 w; w.x = cvtpk(sg[m].x * rs.x, sg[m].y * rs.y); w.y = cvtpk(sg[m].z * rs.z, sg[m].w * rs.w);
                            const bool edge = (u.pm >= 16) && ((sp == 0 && m == 0 && fr == 0) || (sp == 3 && m == 3 && fr == 15));
                            if (!edge) *(u32x2*)(ACT + (size_t)row * DFF + f0 + n * 16) = w; }
                    }
                    __builtin_amdgcn_sched_barrier(0);
                }
            } }
#endif
        asm volatile("s_waitcnt lgkmcnt(0)" ::: "memory"); __builtin_amdgcn_s_barrier(); asm volatile("" ::: "memory");
    }
};

struct EpiProbe {
    static constexpr bool PERM = false, AFTER_DRAIN = false, HAS_BEGIN = false; static constexpr int MID = 0;
    float* sink;
    __device__ __forceinline__ void operator()(const f32x4 (&acc)[2][2][4][2], const pg8::Unit& u, int wr, int wc, int fr, int fq) const {
        f32x4 t = {0.f, 0.f, 0.f, 0.f};
#pragma unroll
        for (int ai = 0; ai < 2; ++ai)
#pragma unroll
            for (int bj = 0; bj < 2; ++bj)
#pragma unroll
                for (int m = 0; m < 4; ++m)
#pragma unroll
                    for (int n = 0; n < 2; ++n) t += acc[ai][bj][m][n];
        if (t.x + t.y + t.z + t.w == 123456.789f) sink[threadIdx.x] = t.x;
    }
};

__device__ __forceinline__ void p_conv_fix(Frame& F, const Args& a) {
    const float* SB = (const float*)(a.ws + WS_SB); bf16* ACT = (bf16*)(a.ws + WS_ACT);
    const int npm = F.xo < 80 ? (80 - F.xo + F.nx - 1) / F.nx : 0;
    const int gtl = (F.rank * NWAVES + F.wave) * 64 + F.lane, NGTL = F.nloc * NWAVES * 64;
    for (int lt = 0; lt < npm; ++lt) { const int pm = F.xo + F.nx * lt; if (pm < 16) continue;
        const int tl = (pm - 16) & 15;
        for (int i = gtl; i < 2 * DFF; i += NGTL) {
            const int which = i / DFF, f = i - which * DFF;
            const int pn = f >> 7, cc = f & 127;
            float gv[2];
#pragma unroll
            for (int bj = 0; bj < 2; ++bj) {
                const int tc = bj * 128 + cc, wi = bj * DFF + f;
                const float* s0 = SB + ((size_t)(pm * 22 + pn) * 4) * 256 + tc;
                float upv, cur, dnv;
                if (which == 0) { cur = s0[0]; dnv = s0[256]; upv = tl > 0 ? SB[((size_t)((pm - 1) * 22 + pn) * 4 + 3) * 256 + tc] : 0.f; }
                else { cur = s0[3 * 256]; upv = s0[2 * 256]; dnv = tl < 15 ? SB[((size_t)((pm + 1) * 22 + pn) * 4) * 256 + tc] : 0.f; }
                gv[bj] = a.conv_w[wi] * upv + a.conv_w[UPW + wi] * cur + a.conv_w[2 * UPW + wi] * dnv + a.conv_b[wi];
            }
            const int row = pm * 256 + (which ? 255 : 0);
            ACT[(size_t)row * DFF + f] = (bf16)f2bf(siluf(gv[0]) * gv[1]);
        }
    }
}

__device__ __forceinline__ int crow(int r, int hh) { return (r & 3) + 8 * (r >> 2) + 4 * hh; }
struct AttnSt { float m, l; f32x16 o0, o1; };
constexpr int AK_STRIDE = 272, AV_STRIDE = 136, AK_BYTES = 64 * AK_STRIDE, AV_BYTES = 128 * AV_STRIDE;
constexpr int ATT_KOFF = 0, ATT_VOFF = 2 * AK_BYTES, ATT_SQOFF = 2 * AK_BYTES + 2 * AV_BYTES;
template <bool MASK> __device__ __forceinline__ void attn_tile(AttnSt& st, const bf16x8 (&qf)[4], const LAS unsigned char* kt, const LAS unsigned char* vt, int ts, int Lk, int qi, int ql, int hh) {
    f32x16 p0 = {}, p1 = {};
    const LAS unsigned char* kp0 = kt + ql * AK_STRIDE + 16 * hh; const LAS unsigned char* kp1 = kp0 + 32 * AK_STRIDE;
    const LAS unsigned char* vp = vt + ql * AV_STRIDE + 8 * hh;
    bf16x8 ka[4], kb[4];
    u32x2 va[2][2][2][2];
#pragma unroll
    for (int s = 0; s < 4; ++s) { ka[s] = *(const LAS bf16x8*)(kp0 + 32 * s); kb[s] = *(const LAS bf16x8*)(kp1 + 32 * s); }
#pragma unroll
    for (int s = 0; s < 2; ++s)
#pragma unroll
        for (int db = 0; db < 2; ++db) { const LAS unsigned char* a0 = vp + db * 32 * AV_STRIDE + 32 * s; va[0][s][db][0] = *(const LAS u32x2*)a0; va[0][s][db][1] = *(const LAS u32x2*)(a0 + 16); }
    __builtin_amdgcn_sched_barrier(0);
#pragma unroll
    for (int s = 0; s < 4; ++s) { p0 = __builtin_amdgcn_mfma_f32_32x32x16_bf16(ka[s], qf[s], p0, 0, 0, 0); p1 = __builtin_amdgcn_mfma_f32_32x32x16_bf16(kb[s], qf[s], p1, 0, 0, 0); }
    __builtin_amdgcn_sched_barrier(0);
#pragma unroll
    for (int s = 0; s < 2; ++s)
#pragma unroll
        for (int db = 0; db < 2; ++db) { const LAS unsigned char* a0 = vp + db * 32 * AV_STRIDE + 64 + 32 * s; va[1][s][db][0] = *(const LAS u32x2*)a0; va[1][s][db][1] = *(const LAS u32x2*)(a0 + 16); }
    __builtin_amdgcn_sched_barrier(0);
    if (MASK) {
#pragma unroll
        for (int r = 0; r < 16; ++r) { const int key0 = ts + crow(r, hh), key1 = key0 + 32;
            const bool v0 = key0 >= 0 && key0 < Lk && key0 - qi >= -128 && key0 - qi <= 128;
            const bool v1 = key1 >= 0 && key1 < Lk && key1 - qi >= -128 && key1 - qi <= 128;
            p0[r] = v0 ? p0[r] : -1e30f; p1[r] = v1 ? p1[r] : -1e30f; }
    }
    float mt = p0[0];
#pragma unroll
    for (int r = 1; r < 16; ++r) mt = fmaxf(mt, p0[r]);
#pragma unroll
    for (int r = 0; r < 16; ++r) mt = fmaxf(mt, p1[r]);
    mt = max_x32(mt);
    const float mn = fmaxf(st.m, mt);
    if (__builtin_amdgcn_ballot_w64(mn != st.m) != 0ull) {
        const float alpha = __builtin_amdgcn_exp2f(st.m - mn);
        st.l *= alpha; st.o0 = st.o0 * alpha; st.o1 = st.o1 * alpha; st.m = mn;
    }
    float ls = 0.f;
#pragma unroll
    for (int r = 0; r < 16; ++r) { p0[r] = __builtin_amdgcn_exp2f(p0[r] - mn); p1[r] = __builtin_amdgcn_exp2f(p1[r] - mn); ls += p0[r] + p1[r]; }
    st.l += ls;
#pragma unroll
    for (int kb2 = 0; kb2 < 2; ++kb2)
#pragma unroll
        for (int s = 0; s < 2; ++s) {
            const f32x16& p = kb2 ? p1 : p0;
            v4u bw; bw.x = cvtpk(p[8 * s + 0], p[8 * s + 1]); bw.y = cvtpk(p[8 * s + 2], p[8 * s + 3]); bw.z = cvtpk(p[8 * s + 4], p[8 * s + 5]); bw.w = cvtpk(p[8 * s + 6], p[8 * s + 7]);
            const bf16x8 bfrag = __builtin_bit_cast(bf16x8, bw);
#pragma unroll
            for (int db = 0; db < 2; ++db) {
                v4u aw; aw.x = va[kb2][s][db][0].x; aw.y = va[kb2][s][db][0].y; aw.z = va[kb2][s][db][1].x; aw.w = va[kb2][s][db][1].y;
                const bf16x8 afrag = __builtin_bit_cast(bf16x8, aw);
                if (db == 0) st.o0 = __builtin_amdgcn_mfma_f32_32x32x16_bf16(afrag, bfrag, st.o0, 0, 0, 0);
                else st.o1 = __builtin_amdgcn_mfma_f32_32x32x16_bf16(afrag, bfrag, st.o1, 0, 0, 0);
            }
        }
}

struct AttnStage { v4u k[2], v[2]; };
__device__ __forceinline__ void attn_stage_load(AttnStage& sg, const bf16* kbase, const bf16* vtbase, int vds, int ts, int Lk, int tid) {
#pragma unroll
    for (int i = 0; i < 2; ++i) { const int idx = tid + 512 * i;
        int key = ts + (idx >> 4); key = key < 0 ? 0 : (key >= Lk ? Lk - 1 : key);
        sg.k[i] = *(const v4u*)(kbase + (size_t)key * 128 + (idx & 15) * 8);
        int tok = ts + (idx & 7) * 8; tok = tok < 0 ? 0 : (tok >= Lk ? Lk - 8 : tok);
        sg.v[i] = *(const v4u*)(vtbase + (size_t)(idx >> 3) * vds + tok); }
}
__device__ __forceinline__ void attn_stage_store(const AttnStage& sg, LAS unsigned char* kt, LAS unsigned char* vt, int tid) {
#pragma unroll
    for (int i = 0; i < 2; ++i) { const int idx = tid + 512 * i;
        *(LAS v4u*)(kt + (idx >> 4) * AK_STRIDE + (idx & 15) * 16) = sg.k[i];
        LAS unsigned char* vd = vt + (idx >> 3) * AV_STRIDE + (idx & 7) * 16;
        u32x2 a, b; a.x = sg.v[i].x; a.y = sg.v[i].y; b.x = sg.v[i].z; b.y = sg.v[i].w;
        *(LAS u32x2*)vd = a; *(LAS u32x2*)(vd + 8) = b; }
}

template <int MODE> __device__ __forceinline__ void attn_unit(Frame& F, const Args& a, int is_lat, int b, int qb) {
    const int h = F.wave, kvh = h >> 2, ql = F.lane & 31, hh = F.lane >> 5;
    const int L = is_lat ? 4096 : 256, row0 = is_lat ? NCTX + b * 4096 : b * 256, q0 = qb * 32;
    const bf16* Q = (const bf16*)(a.ws + WS_Q); const bf16* Kb = (const bf16*)(a.ws + WS_K); const bf16* VT = (const bf16*)(a.ws + WS_VT);
    const bf16* kloc = Kb + (size_t)row0 * 128;
    const bf16* vloc = VT + row0;
    const bf16* kctx = (const bf16*)(a.ws + WS_CTXK) + (size_t)b * 512 * 128;
    const bf16* vctx = (const bf16*)(a.ws + WS_CTXVT) + (size_t)b * 128 * 512;
    const int nt = is_lat ? 13 : 4;
    LAS unsigned char* lds = F.lds;
    AttnStage sg;
#define ATT_LOAD(t) do { if (is_lat && (t) >= 5) attn_stage_load(sg, kctx, vctx, 512, 64 * ((t) - 5), 512, F.tid); \
                         else attn_stage_load(sg, kloc, vloc, NTOK, is_lat ? q0 - 128 + 64 * (t) : 64 * (t), L, F.tid); } while (0)
    ATT_LOAD(0);
    bf16x8 qf[4];
    { const bf16* qp = Q + (size_t)(row0 + q0 + ql) * 512 + h * 64 + 8 * hh;
#pragma unroll
      for (int s = 0; s < 4; ++s) qf[s] = *(const bf16x8*)(qp + 16 * s); }
    AttnSt st; st.m = a.sink[h] * LOG2E; st.l = hh == 0 ? 1.f : 0.f; st.o0 = f32x16{}; st.o1 = f32x16{};
    const int qi = q0 + ql;
    attn_stage_store(sg, lds + ATT_KOFF, lds + ATT_VOFF, F.tid);
    __syncthreads();
    for (int t = 0; t < nt; ++t) {
        const int cur = t & 1;
        if (t + 1 < nt) ATT_LOAD(t + 1);
        const LAS unsigned char* kt = lds + ATT_KOFF + cur * AK_BYTES + kvh * 128;
        const LAS unsigned char* vt = lds + ATT_VOFF + cur * AV_BYTES + kvh * 64 * AV_STRIDE;
        const int tsl = q0 - 128 + 64 * t;
        if (is_lat && t < 5 && (t == 0 || t == 4 || tsl < 0 || tsl + 64 > L)) attn_tile<true>(st, qf, kt, vt, tsl, L, qi, ql, hh);
        else attn_tile<false>(st, qf, kt, vt, 0, 0, qi, ql, hh);
        if (t + 1 < nt) attn_stage_store(sg, lds + ATT_KOFF + (cur ^ 1) * AK_BYTES, lds + ATT_VOFF + (cur ^ 1) * AV_BYTES, F.tid);
        __syncthreads();
    }
#undef ATT_LOAD
    const float lt = sum_x32(st.l), inv = 1.f / lt;
    float ss = 0.f;
#pragma unroll
    for (int r = 0; r < 16; ++r) { st.o0[r] *= inv; st.o1[r] *= inv; ss += st.o0[r] * st.o0[r] + st.o1[r] * st.o1[r]; }
    ss = sum_x32(ss);
    LAS float* sq = (LAS float*)(lds + ATT_SQOFF);
    if (hh == 0) sq[h * 32 + ql] = ss;
    __syncthreads();
    float tot = 0.f;
#pragma unroll
    for (int w = 0; w < 8; ++w) tot += sq[w * 32 + ql];
    const float rstd = rsqrtf(tot * (1.f / 512.f) + RMS_EPS);
    bf16* AO = (bf16*)(a.ws + (MODE ? (size_t)210 * MiB : WS_AO)) + (size_t)(row0 + q0 + ql) * DM + (MK_FUSE5 ? 512 : 0) + h * 64;
#pragma unroll
    for (int db = 0; db < 2; ++db)
#pragma unroll
        for (int rq = 0; rq < 4; ++rq) { const int d0 = 32 * db + 8 * rq + 4 * hh; const f32x4 g = *(const f32x4*)(a.g_attn + h * 64 + d0);
            const f32x16& o = db ? st.o1 : st.o0;
            u32x2 w; w.x = cvtpk(o[4 * rq] * rstd * g.x, o[4 * rq + 1] * rstd * g.y); w.y = cvtpk(o[4 * rq + 2] * rstd * g.z, o[4 * rq + 3] * rstd * g.w);
            *(u32x2*)(AO + d0) = w; }
    __syncthreads();
}

struct Cx { float r, i; };
__device__ __forceinline__ Cx cmul(Cx a, Cx b) { return Cx{a.r * b.r - a.i * b.i, a.r * b.i + a.i * b.r}; }
__device__ __forceinline__ Cx cfma(Cx a, Cx b, Cx c) { return Cx{a.r * b.r - a.i * b.i + c.r, a.r * b.i + a.i * b.r + c.i}; }
__device__ __forceinline__ Cx cstep(Cx a, Cx h, float br, float bi) {
#if MK_NOASM
    return cfma(a, h, Cx{br, bi});
#endif
    float t0, t1, r, i;
    asm("v_fma_f32 %0, %1, %2, %3" : "=v"(t0) : "v"(a.r), "v"(h.r), "v"(br));
    asm("v_fma_f32 %0, %1, %2, %3" : "=v"(t1) : "v"(a.r), "v"(h.i), "v"(bi));
    asm("v_fma_f32 %0, -%1, %2, %3" : "=v"(r) : "v"(a.i), "v"(h.i), "v"(t0));
    asm("v_fma_f32 %0, %1, %2, %3" : "=v"(i) : "v"(a.i), "v"(h.r), "v"(t1));
    return Cx{r, i};
}
#define MFMA_PAD2(x, y) asm volatile("s_nop 15\n\ts_nop 7" : "+v"(x), "+v"(y))
__device__ __forceinline__ float shx32(float v) {
    const auto rr = __builtin_amdgcn_permlane32_swap(__float_as_uint(v), __float_as_uint(v), false, false);
    return __uint_as_float(((int)__builtin_amdgcn_mbcnt_hi(~0u, __builtin_amdgcn_mbcnt_lo(~0u, 0u)) >= 32) ? rr[0] : rr[1]);
}
__device__ __forceinline__ Cx cshx(Cx a) { return Cx{shx32(a.r), shx32(a.i)}; }
struct SegInfo { int L, row0, nseg, segbase, sl, isl, seq; };
__device__ __forceinline__ SegInfo seg_info(int sg) {
    SegInfo s;
    if (sg < 32) { s.isl = 0; s.seq = sg >> 1; s.L = 256; s.row0 = s.seq * 256; s.nseg = 2; s.segbase = s.seq * 2; s.sl = sg & 1; }
    else { const int t = sg - 32; s.isl = 1; s.seq = t >> 5; s.L = 4096; s.row0 = NCTX + s.seq * 4096; s.nseg = 32; s.segbase = 32 + s.seq * 32; s.sl = t & 31; }
    return s;
}
__device__ __forceinline__ int bu_pos(int i) { return 64 * ((i >> 2) & 1) + (i & 3) + 4 * (i >> 3); }

__device__ __forceinline__ void ssm_pass_a(Frame& F, const Args& a, int unit) {
    const int sg = unit >> 6, gi = unit & 63, dr = gi >> 5, g = gi & 31;
    const SegInfo si = seg_info(sg);
    const int c = F.lane & 31, hh = F.lane >> 5;
    const unsigned char* cb = a.ws + WS_SSMC + (size_t)gi * 16384;
    const bf16* BBm = (const bf16*)cb; const float* AP = (const float*)(cb + 8192);
    bf16x8 bb[4];
#pragma unroll
    for (int q = 0; q < 4; ++q) bb[q] = *(const bf16x8*)(BBm + (q * 32 + c) * 16 + 8 * hh);
    const Cx a0{AP[c], AP[64 + c]}, a1{AP[32 + c], AP[96 + c]}, a64_0{AP[128 + c], AP[192 + c]}, a64_1{AP[160 + c], AP[224 + c]};
    const bf16* U = (const bf16*)(a.ws + WS_U);
    Cx S0{0.f, 0.f}, S1{0.f, 0.f};
    const int pi = bu_pos(c);
    bf16x8 uav[4];
#pragma unroll
    for (int blk = 0; blk < 4; ++blk) { const int p = si.sl * 128 + blk * 16 + pi; const int tok = dr ? si.L - 1 - p : p; uav[blk] = *(const bf16x8*)(U + (size_t)(si.row0 + tok) * 512 + g * 16 + 8 * hh); }
#pragma unroll
    for (int blk = 0; blk < 4; ++blk) {
        const f32x16 z = {};
        f32x16 b0 = __builtin_amdgcn_mfma_f32_32x32x16_bf16(uav[blk], bb[0], z, 0, 0, 0), b1 = __builtin_amdgcn_mfma_f32_32x32x16_bf16(uav[blk], bb[1], z, 0, 0, 0);
        f32x16 b2 = __builtin_amdgcn_mfma_f32_32x32x16_bf16(uav[blk], bb[2], z, 0, 0, 0), b3 = __builtin_amdgcn_mfma_f32_32x32x16_bf16(uav[blk], bb[3], z, 0, 0, 0);
        MFMA_PAD2(b0, b1); MFMA_PAD2(b2, b3);
#pragma unroll
        for (int r = 0; r < 16; ++r) { S0 = cstep(a0, S0, b0[r], b1[r]); S1 = cstep(a1, S1, b2[r], b3[r]); }
    }
    const Cx x0 = cshx(S0), x1 = cshx(S1);
    const Cx f0 = hh ? x0 : S0, s0 = hh ? S0 : x0, f1 = hh ? x1 : S1, s1 = hh ? S1 : x1;
    const Cx e0 = cfma(a64_0, f0, s0), e1 = cfma(a64_1, f1, s1);
    float* E = (float*)(a.ws + WS_ESEG) + ((size_t)sg * 64 + gi) * 256;
    if (hh == 0) { E[c] = e0.r; E[32 + c] = e0.i; E[64 + c] = e1.r; E[96 + c] = e1.i; E[128 + c] = f0.r; E[160 + c] = f0.i; E[192 + c] = f1.r; E[224 + c] = f1.i; }
}

__device__ __forceinline__ void pass_a_queue(Frame& F, const Args& a, unsigned* cntU, int qoff = 0) {
    const int npm = F.xo < 80 ? (80 - F.xo + F.nx - 1) / F.nx : 0;
    tiles_wait(F, cntU, 0, npm, 4u);
    unsigned* head = (unsigned*)F.ctl + CW_PAQ + qoff + 64 * F.xo;
    volatile LAS unsigned* slot = F.MISC + 40;
    unsigned kn = 0;
    if (F.tid == 0) kn = __hip_atomic_fetch_add(head, 8u, __ATOMIC_RELAXED, __HIP_MEMORY_SCOPE_AGENT);
    for (int it = 0; ; ++it) {
        if (F.tid == 0) { slot[it & 1] = kn; kn = __hip_atomic_fetch_add(head, 8u, __ATOMIC_RELAXED, __HIP_MEMORY_SCOPE_AGENT); }
        __syncthreads();
        const unsigned k0 = slot[it & 1];
        if (k0 >= (unsigned)(npm * 128)) break;
        const unsigned k = k0 + (unsigned)F.wave;
        if (k >= (unsigned)(npm * 128)) continue;
        const int pm = F.xo + F.nx * (int)(k >> 7), tsg = 2 * pm + (int)((k >> 6) & 1), gi = (int)(k & 63);
        const SegInfo si = seg_info(tsg);
        const int sg = (gi >> 5) ? si.segbase + (si.nseg - 1 - si.sl) : tsg;
        ssm_pass_a(F, a, sg * 64 + gi);
    }
}

constexpr int PFB = 8;
template <int MODE> __device__ __forceinline__ void ssm_pass_b(Frame& F, const Args& a, int unit) {
    const int tsg = unit >> 5, g = unit & 31;
    const SegInfo si = seg_info(tsg);
    const int c = F.lane & 31, hh = F.lane >> 5, t16 = F.lane & 15, kq = F.lane >> 4;
    const bf16* U = (const bf16*)(a.ws + WS_U);
    LAS unsigned char* Hl = F.lds + F.wave * 8704;
    f32x4 acc[4][2];
#pragma unroll
    for (int i = 0; i < 4; ++i) { acc[i][0] = f32x4{0.f, 0.f, 0.f, 0.f}; acc[i][1] = f32x4{0.f, 0.f, 0.f, 0.f}; }
    const unsigned char* gb = a.ws + WS_SSMG + (size_t)g * 1024;
    const bf16x4 wg = *(const bf16x4*)((const bf16*)gb + t16 * 16 + 4 * kq);
    const f32x4 dv = *(const f32x4*)((const float*)(gb + 512) + 4 * kq);
    bf16* SS = (bf16*)(a.ws + (MODE ? WS_XN : (MK_FUSE5 ? WS_AO : WS_SS)));
    constexpr int SSW = MK_FUSE5 ? DM : 512;
    float* PS = (float*)(a.ws + (MODE ? (size_t)250 * MiB : WS_PS));
    const int pi = bu_pos(c);
#pragma unroll
    for (int dr = 0; dr < 2; ++dr) {
        const int gi = dr * 32 + g;
        const unsigned char* cb = a.ws + WS_SSMC + (size_t)gi * 16384;
        const bf16* BBm = (const bf16*)cb; const bf16* CM = (const bf16*)(cb + 4096); const float* AP = (const float*)(cb + 8192);
        bf16x8 bb[4], cm[4];
#pragma unroll
        for (int q = 0; q < 4; ++q) { bb[q] = *(const bf16x8*)(BBm + (q * 32 + c) * 16 + 8 * hh); cm[q] = *(const bf16x8*)(CM + t16 * 128 + 32 * q + 8 * kq); }
        const Cx a0{AP[c], AP[64 + c]}, a1{AP[32 + c], AP[96 + c]}, a64_0{AP[128 + c], AP[192 + c]}, a64_1{AP[160 + c], AP[224 + c]}, a128_0{AP[256 + c], AP[320 + c]}, a128_1{AP[288 + c], AP[352 + c]};
        const int psl = dr ? si.nseg - 1 - si.sl : si.sl;
        bf16x8 uav[4];
#pragma unroll
        for (int blk = 0; blk < 4; ++blk) { const int p = psl * 128 + blk * 16 + pi; const int tok = dr ? si.L - 1 - p : p; uav[blk] = *(const bf16x8*)(U + (size_t)(si.row0 + tok) * 512 + g * 16 + 8 * hh); }
        const float* E0 = (const float*)(a.ws + WS_ESEG) + ((size_t)si.segbase * 64 + gi) * 256;
        const Cx ef0{E0[(size_t)psl * 16384 + 128 + c], E0[(size_t)psl * 16384 + 160 + c]}, ef1{E0[(size_t)psl * 16384 + 192 + c], E0[(size_t)psl * 16384 + 224 + c]};
        Cx S0{0.f, 0.f}, S1{0.f, 0.f};
        if (si.isl) { const float* hr = a.st_re + (size_t)si.seq * 4096 + gi * 64; const float* hi_ = a.st_im + (size_t)si.seq * 4096 + gi * 64; S0 = Cx{hr[c], hi_[c]}; S1 = Cx{hr[32 + c], hi_[32 + c]}; }
        for (int ps0 = 0; ps0 < psl; ps0 += PFB) {
            float e[PFB][4];
#pragma unroll
            for (int j = 0; j < PFB; ++j) { const int ps = (ps0 + j < psl) ? ps0 + j : psl - 1; const float* E = E0 + (size_t)ps * 16384;
                e[j][0] = E[c]; e[j][1] = E[32 + c]; e[j][2] = E[64 + c]; e[j][3] = E[96 + c]; }
#pragma unroll
            for (int j = 0; j < PFB; ++j) { const bool ok = ps0 + j < psl; const Cx n0 = cfma(a128_0, S0, Cx{e[j][0], e[j][1]}), n1 = cfma(a128_1, S1, Cx{e[j][2], e[j][3]});
                S0 = ok ? n0 : S0; S1 = ok ? n1 : S1; }
        }
        u32x2 uwv[4][2];
        if (dr == 1) {
#pragma unroll
            for (int tb = 0; tb < 4; ++tb)
#pragma unroll
                for (int th = 0; th < 2; ++th) uwv[tb][th] = *(const u32x2*)(U + (size_t)(si.row0 + si.sl * 128 + 64 * th + 16 * tb + t16) * 512 + g * 16 + 4 * kq);
        }
        if (hh) { S0 = cfma(a64_0, S0, ef0); S1 = cfma(a64_1, S1, ef1); }
        if (MODE == 5) { if (dr == 1) { u32x2 ow; ow.x = __float_as_uint(S0.r + S1.i) ^ uwv[0][0].x; ow.y = __float_as_uint(S0.i + S1.r) ^ uwv[3][1].y ^ (unsigned)bb[0][0] ^ (unsigned)cm[3][1] ^ (unsigned)uav[2][3]; *(u32x2*)(SS + (size_t)(si.row0 + si.sl * 128 + t16) * 512 + g * 16 + 4 * kq) = ow; } continue; }
#pragma unroll
        for (int blk = 0; blk < 4; ++blk) {
            const int tb = dr ? 3 - blk : blk;
            const bf16x8 ua = uav[blk];
#pragma unroll
            for (int nh = 0; nh < 2; ++nh) {
                const f32x16 z = {};
                f32x16 br = __builtin_amdgcn_mfma_f32_32x32x16_bf16(ua, bb[2 * nh], z, 0, 0, 0), bi = __builtin_amdgcn_mfma_f32_32x32x16_bf16(ua, bb[2 * nh + 1], z, 0, 0, 0);
                MFMA_PAD2(br, bi);
                const Cx an = nh ? a1 : a0; Cx h = nh ? S1 : S0;
#pragma unroll
                for (int r = 0; r < 16; ++r) { if (MODE == 2) h = Cx{br[r], bi[r]}; else h = cstep(an, h, br[r], bi[r]); const int pl = 16 * hh + r; const int tl = dr ? 31 - pl : pl;
                    if (MODE != 3) *(LAS unsigned*)(Hl + tl * 272 + 8 * c + 4 * nh) = cvtpk(h.r, h.i); }
                if (nh) S1 = h; else S0 = h;
            }
            asm volatile("s_waitcnt lgkmcnt(0)" ::: "memory");
#pragma unroll
            for (int th = 0; th < 2; ++th)
#pragma unroll
                for (int ks = 0; ks < 4; ++ks) { if (MODE == 3) { acc[tb][th].x += S0.r; continue; } const bf16x8 hf = *(const LAS bf16x8*)(Hl + (16 * th + t16) * 272 + (32 * ks + 8 * kq) * 2);
                    acc[tb][th] = __builtin_amdgcn_mfma_f32_16x16x32_bf16(cm[ks], hf, acc[tb][th], 0, 0, 0); }
            asm volatile("s_waitcnt lgkmcnt(0)" ::: "memory");
            if (dr == 1) {
#pragma unroll
                for (int th = 0; th < 2; ++th) {
                    const int tokn = si.sl * 128 + 64 * th + 16 * tb + t16;
                    const size_t ro = (size_t)(si.row0 + tokn) * SSW + g * 16 + 4 * kq;
                    const u32x2 uw = uwv[tb][th];
                    f32x4 y = acc[tb][th];
                    y.x += bf2f((unsigned short)(uw.x & 0xffffu)) * dv.x; y.y += bf2f((unsigned short)(uw.x >> 16)) * dv.y;
                    y.z += bf2f((unsigned short)(uw.y & 0xffffu)) * dv.z; y.w += bf2f((unsigned short)(uw.y >> 16)) * dv.w;
                    f32x4 x; x.x = gelu_tanh(y.x); x.y = gelu_tanh(y.y); x.z = gelu_tanh(y.z); x.w = gelu_tanh(y.w);
                    u32x2 xb; xb.x = cvtpk(x.x, x.y); xb.y = cvtpk(x.z, x.w);
                    const f32x4 zz = __builtin_amdgcn_mfma_f32_16x16x16bf16_1k(wg, __builtin_bit_cast(bf16x4, xb), f32x4{0.f, 0.f, 0.f, 0.f}, 0, 0, 0);
                    const float o0 = x.x * fast_sigmoid(zz.x), o1 = x.y * fast_sigmoid(zz.y), o2 = x.z * fast_sigmoid(zz.z), o3 = x.w * fast_sigmoid(zz.w);
                    u32x2 ow; ow.x = cvtpk(o0, o1); ow.y = cvtpk(o2, o3);
                    *(u32x2*)(SS + ro) = ow;
                    if (MK_FUSE5) { const float q = sum_x32(sum_x16((o0 * o0 + o1 * o1) + (o2 * o2 + o3 * o3))); if (kq == 0) PS[(size_t)(si.row0 + tokn) * 32 + g] = q; }
                }
            }
        }
        if (MODE == 0 && !si.isl && psl == si.nseg - 1 && hh == 1) {
            float* ore = a.out + 22020096 + (size_t)(si.seq * 2 + dr) * 2048 + g * 64; float* oim = ore + 65536;
            ore[c] = S0.r; ore[32 + c] = S1.r; oim[c] = S0.i; oim[32 + c] = S1.i;
        }
    }
}

__device__ __forceinline__ void p_ssm_norm(Frame& F, const Args& a) {
    const int gw = (int)blockIdx.x * NWAVES + F.wave, NGW = F.G * NWAVES;
    const bf16* SS = (const bf16*)(a.ws + WS_SS); bf16* AO = (bf16*)(a.ws + WS_AO);
    for (int row = gw; row < NTOK; row += NGW) {
        const v4u w = *(const v4u*)(SS + (size_t)row * 512 + 8 * F.lane);
        float v[8]; v[0] = bf2f(w.x & 0xffff); v[1] = bf2f(w.x >> 16); v[2] = bf2f(w.y & 0xffff); v[3] = bf2f(w.y >> 16); v[4] = bf2f(w.z & 0xffff); v[5] = bf2f(w.z >> 16); v[6] = bf2f(w.w & 0xffff); v[7] = bf2f(w.w >> 16);
        float s = 0.f;
#pragma unroll
        for (int j = 0; j < 8; ++j) s += v[j] * v[j];
        const float rstd = rsqrtf(wave_sum(s) * (1.f / 512.f) + RMS_EPS);
        const f32x4 g0 = *(const f32x4*)(a.g_ssm + 8 * F.lane), g1 = *(const f32x4*)(a.g_ssm + 8 * F.lane + 4);
        v4u o; o.x = cvtpk(v[0] * rstd * g0.x, v[1] * rstd * g0.y); o.y = cvtpk(v[2] * rstd * g0.z, v[3] * rstd * g0.w); o.z = cvtpk(v[4] * rstd * g1.x, v[5] * rstd * g1.y); o.w = cvtpk(v[6] * rstd * g1.z, v[7] * rstd * g1.w);
        *(v4u*)(AO + (size_t)row * DM + 512 + 8 * F.lane) = o;
    }
}

__device__ __forceinline__ void p_final_norm(Frame& F, const Args& a, unsigned* cnt = nullptr) {
    ROWS_AFFINE_BEGIN(F, row, cnt, 4, MK_HALVES) {
        int rw[2] = {row, row2};
        f32x4 v[2][4]; float s[2] = {0.f, 0.f};
#pragma unroll
        for (int q = 0; q < 2; ++q)
#pragma unroll
            for (int j = 0; j < 4; ++j) v[q][j] = *(const f32x4*)(a.out + (size_t)rw[q] * DM + 4 * F.lane + 256 * j);
#pragma unroll
        for (int q = 0; q < 2; ++q)
#pragma unroll
            for (int j = 0; j < 4; ++j) s[q] += (v[q][j].x * v[q][j].x + v[q][j].y * v[q][j].y) + (v[q][j].z * v[q][j].z + v[q][j].w * v[q][j].w);
#pragma unroll
        for (int q = 0; q < 2; ++q) { if (q == 1 && !has2) break;
            const float rstd = rsqrtf(wave_sum(s[q]) * (1.f / DM) + RMS_EPS);
#pragma unroll
            for (int j = 0; j < 4; ++j) { const f32x4 g = *(const f32x4*)(a.g_final + 4 * F.lane + 256 * j); *(f32x4*)(a.out + (size_t)rw[q] * DM + 4 * F.lane + 256 * j) = v[q][j] * rstd * g; } }
    } ROWS_AFFINE_END
}

__device__ __forceinline__ void l2_thrash(Frame& F, const Args& a, int salt) {
    const f32x4* p = (const f32x4*)(a.x_sample) + ((size_t)((blockIdx.x + 37 * salt) & 255) * 16384) + F.tid;
    f32x4 s = {0.f, 0.f, 0.f, 0.f};
#pragma unroll 8
    for (int i = 0; i < 32; ++i) s += p[(size_t)i * 512];
    if (s.x + s.y + s.z + s.w == 123456.789f) a.out[22151167] = s.x;
}
#ifndef MK_NRUN
#define MK_NRUN N_PHASES
#endif
#ifndef MK_DIAG_TWICE
#define MK_DIAG_TWICE 0
#endif
#if MK_DIAG_TWICE
__global__ void diag_compare(const unsigned* a, const unsigned* b, int n, unsigned* cnt) {
    unsigned c = 0;
    for (int i = blockIdx.x * blockDim.x + threadIdx.x; i < n; i += gridDim.x * blockDim.x) c += (a[i] != b[i]) ? 1u : 0u;
    if (c) atomicAdd(cnt, c);
}
__global__ void diag_apply(float* y, int n, const unsigned* cnt) {
    if (!cnt[0]) return;
    const unsigned c = cnt[0]; const int b = c < 16u ? 0 : c < 256u ? 1 : c < 4096u ? 2 : c < 65536u ? 3 : c < 1048576u ? 4 : 5;
    const float s = 1.f + 1.5f + 0.25f * (float)b;
    for (int i = blockIdx.x * blockDim.x + threadIdx.x; i < n; i += gridDim.x * blockDim.x) y[i] *= s;
}
#endif
#ifndef MK_THRASH
#define MK_THRASH 1
#endif
#ifndef MK_OVERLAP
#define MK_OVERLAP 3
#endif
#define OV6 ((MK_OVERLAP) & 1)
#define OV10 (((MK_OVERLAP) >> 1) & 1)
#ifndef MK_SHADOW
#define MK_SHADOW 0
#endif
#ifndef MK_REPEAT_MASK
#define MK_REPEAT_MASK 0x0
#endif
#ifndef MK_CUTMASK
#define MK_CUTMASK 0
#endif
#define MK_PER_PHASE (MK_CUTMASK == 0x7FF)
constexpr int N_PHASES = 12;
__global__ void __launch_bounds__(NWAVES * 64, 2) __attribute__((target("no-packed-fp32-ops"))) mega_fwd(Args args) {
    extern __shared__ __attribute__((aligned(16))) unsigned char lds[];
    Frame F;
    F.lds = (LAS unsigned char*)lds;
    F.MISC = (volatile LAS unsigned*)(F.lds + MISC_OFF);
    F.tid = threadIdx.x; F.lane = F.tid & 63; F.wave = __builtin_amdgcn_readfirstlane(F.tid >> 6);
    F.G = gridDim.x;
    F.ctl = (gu32*)(args.ws + WS_CTL);
    for (int u = F.tid; u < (LDS_BYTES - LDSCTL_OFF) / 4; u += NWAVES * 64) ((LAS unsigned*)(F.lds + LDSCTL_OFF))[u] = 0u;
    __syncthreads();
    XcdBarrier bar = xcd_barrier_post((unsigned*)(F.ctl + CW_BAR) + args.li * XCD_BAR_WORDS, F.MISC + 8);
    if (F.tid == 0) {
        unsigned* rk = (unsigned*)(F.ctl + CW_RANK) + args.li * 1024;
        const unsigned rank = xb_add(&rk[64 * bar.x], 1u);
        unsigned nloc, nx; xcd_barrier_complete(bar.bar, bar.x, nloc, nx); bar.st[0] = nloc; bar.st[1] = nx;
        unsigned ord = 0;
        for (unsigned j = 0; j < 16; ++j) { const unsigned c = xb_ld(&bar.bar[XB_XCNT(j)]); if (j < bar.x && c > 0u) ++ord; }
        F.MISC[10] = ord; F.MISC[11] = rank; F.MISC[12] = nloc; F.MISC[13] = nx;
    }
    __syncthreads();
    F.xo = (int)F.MISC[10]; F.rank = (int)F.MISC[11]; F.nloc = (int)F.MISC[12]; F.nx = (int)F.MISC[13];
    F.xo = __builtin_amdgcn_readfirstlane(F.xo); F.rank = __builtin_amdgcn_readfirstlane(F.rank); F.nloc = __builtin_amdgcn_readfirstlane(F.nloc); F.nx = __builtin_amdgcn_readfirstlane(F.nx);
#define GRID_BAR() do { if (!MK_PER_PHASE) xcd_barrier(bar); } while (0)
    const int lo = args.ph_lo, hi = args.ph_hi;
#ifndef MK_PHASE_MASK
#define MK_PHASE_MASK 0xFFF
#endif
#define IN(k) (((MK_PHASE_MASK >> (k)) & 1) && lo <= (k) && (k) < hi)
#define SEAM(k) do { if (IN(k) && IN((k) + 1)) GRID_BAR(); } while (0)
#define SEAM_L(k) do { if (IN(k) && IN((k) + 1)) { if (MK_LIGHT) { if (!MK_PER_PHASE) xcd_barrier_local(bar); } else GRID_BAR(); } } while (0)
    unsigned char* ws = args.ws;

    if (IN(0)) for (int rep_ = 0; rep_ < (((MK_REPEAT_MASK >> 0) & 1) ? 2 : 1); ++rep_) { if (rep_) GRID_BAR(); p0_setup(F, args); } SEAM(0);
    if (IN(1)) for (int rep_ = 0; rep_ < (((MK_REPEAT_MASK >> 1) & 1) ? 2 : 1); ++rep_) { if (rep_) GRID_BAR(); p_modulate(F, args, 0); } SEAM_L(1);
    if (IN(2)) for (int rep_ = 0; rep_ < (((MK_REPEAT_MASK >> 2) & 1) ? 2 : 1); ++rep_) { if (rep_) GRID_BAR();
        pg8::Gemm g{(const pg8::bf16_t*)(ws + WS_XN), (const pg8::bf16_t*)(ws + WS_WIN), NTOK, INW, DM}; XcdOrder S; S.init(NTOK, INW, F);
        unsigned* cntU = (unsigned*)F.ctl + CW_TCNT + 16384 + rep_ * 8192;
        if (MK_PAQ) { S.rot = 3; S.cpn = 3; S.cnt = cntU; }
        EpiInProj E{(bf16*)(ws + WS_Q), (bf16*)(ws + WS_K), (bf16*)(ws + WS_VT), (bf16*)(ws + WS_U), args.out + 20971520, args.out + 21495808, (const float*)(ws + WS_ROPE), (const float*)(ws + WS_ROPE) + 1024};
        pg8::gemm_phase<EpiInProj, XcdOrder, true, true>(F.lds + RING_OFF, g, S, E);
        if (MK_PAQ) pass_a_queue(F, args, cntU, rep_ * 2048);
        if (MK_TQ) { __syncthreads(); transpose_queue(F, args); }
#if MK_SHADOW == 30
        GRID_BAR(); pass_a_queue(F, args, cntU, 4096);
#endif
    } SEAM(2);
    if (IN(3)) for (int rep_ = 0; rep_ < (((MK_REPEAT_MASK >> 3) & 1) ? 2 : 1); ++rep_) { if (rep_) GRID_BAR();
        const int gw = (int)blockIdx.x * NWAVES + F.wave, NGW = F.G * NWAVES;
        if (!MK_PAQ) for (int u = gw; u < NSEG * 64; u += NGW) ssm_pass_a(F, args, u);
        __syncthreads();
        for (int u = blockIdx.x; u < (MK_CTXB ? 512 : 640); u += F.G) { if (u < 512) attn_unit<0>(F, args, 1, u >> 7, u & 127); else attn_unit<0>(F, args, 0, (u - 512) >> 3, (u - 512) & 7); }
#if MK_SHADOW == 10
        GRID_BAR();
        for (int u = blockIdx.x; u < 640; u += F.G) { if (u < 512) attn_unit<1>(F, args, 1, u >> 7, u & 127); else attn_unit<1>(F, args, 0, (u - 512) >> 3, (u - 512) & 7); }
#endif
    } SEAM(3);
    if (IN(4)) for (int rep_ = 0; rep_ < (((MK_REPEAT_MASK >> 4) & 1) ? 2 : 1); ++rep_) { if (rep_) GRID_BAR();
        int gw = (int)blockIdx.x * NWAVES + F.wave; const int NGW = F.G * NWAVES;
        if (MK_CTXB) { for (int u = 512 + blockIdx.x; u < 640; u += F.G) attn_unit<0>(F, args, 0, (u - 512) >> 3, (u - 512) & 7);
            gw = (gw + NGW / 2) % NGW; }
        for (int u = gw; u < NSEG * 32; u += NGW) ssm_pass_b<0>(F, args, u);
#if MK_SHADOW > 0 && MK_SHADOW < 10
        GRID_BAR();
        for (int u = gw; u < NSEG * 32; u += NGW) ssm_pass_b<MK_SHADOW>(F, args, u);
#endif
    } SEAM(4);
    if (!MK_FUSE5) { if (IN(5)) for (int rep_ = 0; rep_ < (((MK_REPEAT_MASK >> 5) & 1) ? 2 : 1); ++rep_) { if (rep_) GRID_BAR(); p_ssm_norm(F, args); } SEAM(5); }
    if (IN(6)) for (int rep_ = 0; rep_ < (((MK_REPEAT_MASK >> 6) & 1) ? 2 : 1); ++rep_) { if (rep_) GRID_BAR();
        unsigned* cnt = OV6 ? (unsigned*)F.ctl + CW_TCNT : nullptr;
        pg8::Gemm g{(const pg8::bf16_t*)(ws + WS_AO), (const pg8::bf16_t*)(ws + WS_WOUT), NTOK, DM, DM}; XcdOrder S; S.init(NTOK, DM, F, OV6, cnt);
        EpiResid<false> E{args.x_prompt, args.x_sample, (const float*)(ws + WS_MOD), args.out, 2048};
        if (MK_FUSE5) { S.ps = (const float*)(ws + WS_PS); S.rs = (LAS float*)(F.lds + XBUF_OFF); E.rs = S.rs; }
        pg8::gemm_phase<EpiResid<false>, XcdOrder, true, true>(F.lds + RING_OFF, g, S, E);
        if (OV6) p_modulate(F, args, 1, cnt);
    } if (OV6) SEAM_L(6); else SEAM(6);
    if (IN(7)) for (int rep_ = 0; rep_ < (((MK_REPEAT_MASK >> 7) & 1) ? 2 : 1); ++rep_) { if (rep_) GRID_BAR(); if (!OV6) p_modulate(F, args, 1); } if (!OV6) SEAM(7);
    if (IN(8)) for (int rep_ = 0; rep_ < (((MK_REPEAT_MASK >> 8) & 1) ? 2 : 1); ++rep_) { if (rep_) GRID_BAR();
        pg8::Gemm g{(const pg8::bf16_t*)(ws + WS_XN), (const pg8::bf16_t*)(ws + WS_WUP), NTOK, UPW, DM}; XcdOrder S; S.init(NTOK, UPW, F);
        EpiUpConv E{(bf16*)(ws + WS_ACT), (float*)(ws + WS_SB), args.conv_w, args.conv_b, (LAS float*)(F.lds + XBUF_OFF), (LAS float*)(F.lds + CWL_OFF)};
        pg8::gemm_phase<EpiUpConv, XcdOrder, true, true>(F.lds + RING_OFF, g, S, E);
#if MK_SHADOW == 20 || MK_SHADOW == 21
        GRID_BAR();
        { pg8::Gemm g2{(const pg8::bf16_t*)(ws + WS_XN), (const pg8::bf16_t*)(ws + WS_WUP), NTOK, UPW, DM}; XcdOrder S2; S2.init(NTOK, UPW, F);
          if (MK_SHADOW == 20) { EpiProbe E2{(float*)(ws + 250 * MiB)}; pg8::gemm_phase<EpiProbe, XcdOrder, true, true>(F.lds + RING_OFF, g2, S2, E2); }
          else { EpiUpConv E2{(bf16*)(ws + WS_ACT), (float*)(ws + WS_SB), args.conv_w, args.conv_b, (LAS float*)(F.lds + XBUF_OFF), (LAS float*)(F.lds + CWL_OFF)}; pg8::gemm_phase<EpiUpConv, XcdOrder, true, true>(F.lds + RING_OFF, g2, S2, E2); } }
#endif
    } SEAM(8);
    if (IN(9)) for (int rep_ = 0; rep_ < (((MK_REPEAT_MASK >> 9) & 1) ? 2 : 1); ++rep_) { if (rep_) GRID_BAR(); p_conv_fix(F, args); } SEAM_L(9);
    if (IN(10)) for (int rep_ = 0; rep_ < (((MK_REPEAT_MASK >> 10) & 1) ? 2 : 1); ++rep_) { if (rep_) GRID_BAR();
        unsigned* cnt = OV10 ? (unsigned*)F.ctl + CW_TCNT + 8192 : nullptr;
        pg8::Gemm g{(const pg8::bf16_t*)(ws + WS_ACT), (const pg8::bf16_t*)(ws + WS_WDN), NTOK, DM, DFF}; XcdOrderT<(OV10 && MK_HALVES)> S; S.init(NTOK, DM, F, OV10, cnt);
        EpiResid<true> E{nullptr, nullptr, (const float*)(ws + WS_MOD), args.out, 5120};
        pg8::gemm_phase<EpiResid<true>, XcdOrderT<(OV10 && MK_HALVES)>, true, true>(F.lds + RING_OFF, g, S, E);
        if (OV10) p_final_norm(F, args, cnt);
    } if (!OV10) SEAM(10);
    if (IN(11)) for (int rep_ = 0; rep_ < (((MK_REPEAT_MASK >> 11) & 1) ? 2 : 1); ++rep_) { if (rep_) GRID_BAR(); if (!OV10) p_final_norm(F, args); }
#undef IN
#undef SEAM
#undef SEAM_L
}

extern "C" void kernel_launch(void* const* d_in, const int* in_sizes, int n_in, void* d_out, int out_size, void* d_ws, size_t ws_size, hipStream_t stream) {
    static int grid = 0;
    if (grid == 0) {
        if (n_in != 31 || ws_size < WS_END) { fprintf(stderr, "kernel_launch: unexpected inputs (n_in %d, ws %zu)\n", n_in, ws_size); grid = -1; return; }
        int dev = 0, cus = 0, per_cu = 0;
        if (hipGetDevice(&dev) != hipSuccess || hipDeviceGetAttribute(&cus, hipDeviceAttributeMultiprocessorCount, dev) != hipSuccess) { grid = -1; return; }
        if (hipFuncSetAttribute((const void*)mega_fwd, hipFuncAttributeMaxDynamicSharedMemorySize, LDS_BYTES) != hipSuccess) { fprintf(stderr, "kernel_launch: hipFuncSetAttribute failed\n"); grid = -1; return; }
        if (hipOccupancyMaxActiveBlocksPerMultiprocessor(&per_cu, (const void*)mega_fwd, NWAVES * 64, LDS_BYTES) != hipSuccess || per_cu < 1) fprintf(stderr, "kernel_launch: occupancy query reports %d\n", per_cu);
        (void)hipGetLastError();
        grid = cus;
    }
    if (grid < 0) return;
    Args a{};
    const float** ap = (const float**)&a;
    for (int i = 0; i < 31; ++i) ap[i] = (const float*)d_in[i];
    a.out = (float*)d_out; a.ws = (unsigned char*)d_ws;
#if MK_DIAG_TWICE
    static const int rsrc[6] = {128 * 4, 1 * 4, 1 * 4, 1 * 4, 1 * 4, 1 * 4}, rsz[6] = {20 * 4, 1, 1, 1, 1, 1};
    for (int rep = 0; rep < 2; ++rep) {
#endif
#if MK_NANPOISON
    (void)hipMemsetAsync((char*)d_ws + 1 * MiB, 0xFF, (size_t)253 * MiB, stream);
    (void)hipMemsetAsync(d_out, 0xFF, (size_t)out_size * 4, stream);
#endif
    if (hipMemsetAsync((char*)d_ws + WS_CTL, 0, CTL_ZERO_BYTES, stream) != hipSuccess) return;
    { int lo = 0; a.li = 0;
    for (int p = 0; p < MK_NRUN; ++p) if (p == MK_NRUN - 1 || ((MK_CUTMASK >> p) & 1)) { a.ph_lo = lo; a.ph_hi = p + 1; hipLaunchKernelGGL(mega_fwd, dim3(grid), dim3(NWAVES * 64), LDS_BYTES, stream, a); lo = p + 1; ++a.li; } }
#if MK_DIAG_TWICE
    if (rep == 0) { (void)hipMemsetAsync((char*)d_ws + 211 * MiB, 0, 256, stream); size_t dst = 212 * MiB;
        for (int r = 0; r < 6; ++r) { (void)hipMemcpyAsync((char*)d_ws + dst, (char*)d_ws + (size_t)rsrc[r] * (MiB / 4), (size_t)rsz[r] * (MiB / 4), hipMemcpyDeviceToDevice, stream); dst += (size_t)rsz[r] * (MiB / 4); } }
    }
    { size_t dst = 212 * MiB;
      for (int r = 0; r < 6; ++r) { hipLaunchKernelGGL(diag_compare, dim3(1024), dim3(256), 0, stream, (const unsigned*)((char*)d_ws + (size_t)rsrc[r] * (MiB / 4)), (const unsigned*)((char*)d_ws + dst), (int)((size_t)rsz[r] * (MiB / 4) / 4), (unsigned*)((char*)d_ws + 211 * MiB) + r); dst += (size_t)rsz[r] * (MiB / 4); } }
    if (MK_NRUN < N_PHASES) { (void)hipMemsetAsync(d_out, 0, (size_t)20971520 * 4, stream); if (MK_NRUN < 5) (void)hipMemsetAsync((float*)d_out + 22020096, 0, (size_t)131072 * 4, stream); }
    hipLaunchKernelGGL(diag_apply, dim3(1024), dim3(256), 0, stream, (float*)d_out + 20971520, 524288, (const unsigned*)((char*)d_ws + 211 * MiB));
#endif
}
```

```cpp
#include <hip/hip_runtime.h>
#include <cstdio>
#include <cstdint>
#include <cmath>
__device__ __forceinline__ void mk_sync() { __builtin_amdgcn_fence(__ATOMIC_RELEASE, "workgroup"); __builtin_amdgcn_s_barrier(); __builtin_amdgcn_fence(__ATOMIC_ACQUIRE, "workgroup"); }
#define __syncthreads mk_sync
#ifndef MK_EPI_DRAIN
#define MK_EPI_DRAIN 0
#endif
namespace pg8 {
#define PG8_LAS __attribute__((address_space(3)))
typedef unsigned short bf16_t;
typedef short bf16x8 __attribute__((ext_vector_type(8)));
typedef float f32x4 __attribute__((ext_vector_type(4)));
typedef unsigned u32x4 __attribute__((ext_vector_type(4)));
constexpr int BM = 256, BK = 64, HALF = 128, HTB = HALF * BK * 2  , STAGE_BYTES = 8 * HTB, NXCD = 8, WGM = 8;

__host__ __device__ __forceinline__ int lds_byte(int r, int c) { const int st = (r >> 4) * 2 + (c >> 5), rr = r & 15, cc = c & 31, ob = rr * 64 + cc * 2; return st * 1024 + (ob ^ (((ob >> 9) & 1) << 5)); }
__host__ __device__ __forceinline__ void stage_rc(int b, int& R, int& C) { const int st = b / 1024, sb = b % 1024, swz = sb ^ (((sb >> 9) & 1) << 5); R = (st >> 1) * 16 + swz / 64; C = (st & 1) * 32 + (swz % 64) / 2; }
__host__ __device__ __forceinline__ int perm32(int rho) { const int n = rho >> 4, i = rho & 15; return 8 * (i >> 2) + 4 * n + (i & 3); }

struct Unit { int pm, pn, hm; };
struct Gemm { const bf16_t* A; const bf16_t* Bt; int M, N, K; };

struct StaticOrder {
    static constexpr bool HALVES = false;
    int nM, nN, nwg, G, c;
    __host__ __device__ void init(int M, int N, int G_, int c_) { nM = M / BM; nN = N / BM; nwg = nM * nN; G = G_; c = c_; }
    __host__ __device__ bool next(int i, Unit& u) const {
        const long L = (long)i * G + c; if (L >= nwg) return false;
        int wgid = (int)L; { const int q = nwg / NXCD, r = nwg % NXCD, xcd = wgid % NXCD, off = wgid / NXCD; wgid = (xcd < r ? xcd * (q + 1) : r * (q + 1) + (xcd - r) * q) + off; }
        const int nig = WGM * nN, gid = wgid / nig, fm = gid * WGM, gsz = (nM - fm) < WGM ? (nM - fm) : WGM;
        u.pm = fm + ((wgid % nig) % gsz); u.pn = (wgid % nig) / gsz; u.hm = -1; return true;
    }
    __device__ __forceinline__ void a_ready(const Unit&) const {}
    __device__ __forceinline__ void done(const Unit&) const {}
};

__device__ __forceinline__ unsigned cvt_pk_bf16(float lo, float hi) { unsigned r; asm volatile("v_cvt_pk_bf16_f32 %0, %1, %2" : "=v"(r) : "v"(lo), "v"(hi)); return r; }
typedef float f32x2 __attribute__((ext_vector_type(2)));
template <class Epi, class Sched, bool ALIGN_EPI = false, bool SP2 = false>
__device__ __forceinline__ void gemm_phase(PG8_LAS unsigned char* lds, const Gemm g, const Sched& S, const Epi& E) {
    const int tid = threadIdx.x, wid = __builtin_amdgcn_readfirstlane(tid >> 6), lane = tid & 63, wr = wid >> 2, wc = wid & 3, fr = lane & 15, fq = lane >> 4;
    const int K = g.K, nt = K / BK;
    unsigned voffA[2], voffB[2];
#pragma unroll
    for (int i = 0; i < 2; ++i) { int R, C; stage_rc(tid * 16 + i * 8192, R, C); const int Rb = Epi::PERM ? ((R & ~31) + perm32(R & 31)) : R;
        voffA[i] = (unsigned)(R * K + C) * 2u; voffB[i] = (unsigned)(Rb * K + C) * 2u; }
    const size_t kstep = (size_t)(BK * 2);
    const size_t hstep = (size_t)HALF * K * 2;
    const size_t tstep = 2 * hstep;
    const unsigned ldsw = (unsigned)wid * 1024u;
    const int aoff = lds_byte(wr * 64 + fr, fq * 8), boff = lds_byte(wc * 32 + fr, fq * 8);
#define PG8_SA(b, h) (((b) * 2 + (h)) * HTB)
#define PG8_SB(b, h) ((4 + (b) * 2 + (h)) * HTB)
#define PG8_STAGE(bufoff, gbase, voff) do { _Pragma("unroll") for (int _i = 0; _i < 2; ++_i) \
        __builtin_amdgcn_global_load_lds((const unsigned*)((const char*)(gbase) + (voff)[_i]), (PG8_LAS unsigned*)(lds + (bufoff) + ldsw + _i * 8192), 16, 0, 0); } while (0)
#define PG8_LDA(dst, b, h) do { _Pragma("unroll") for (int m = 0; m < 4; ++m) _Pragma("unroll") for (int k = 0; k < 2; ++k) dst[m][k] = *(const PG8_LAS bf16x8*)(lds + PG8_SA(b, h) + aoff + m * 2048 + k * 1024); } while (0)
#define PG8_LDB(dst, b, h) do { _Pragma("unroll") for (int n = 0; n < 2; ++n) _Pragma("unroll") for (int k = 0; k < 2; ++k) dst[n][k] = *(const PG8_LAS bf16x8*)(lds + PG8_SB(b, h) + boff + n * 2048 + k * 1024); } while (0)
#define PG8_MMA(ai, bj, At, Bt) do { __builtin_amdgcn_s_setprio(1); _Pragma("unroll") for (int m = 0; m < 4; ++m) _Pragma("unroll") for (int n = 0; n < 2; ++n) _Pragma("unroll") for (int k = 0; k < 2; ++k) \
        acc[ai][bj][m][n] = __builtin_amdgcn_mfma_f32_16x16x32_bf16(Bt[n][k], At[m][k], acc[ai][bj][m][n], 0, 0, 0); __builtin_amdgcn_s_setprio(0); } while (0)
#define PG8_WAIT_V(n) asm volatile("s_waitcnt vmcnt(" #n ")" ::: "memory")
#define PG8_WAIT_L(n) asm volatile("s_waitcnt lgkmcnt(" #n ")" ::: "memory")
#define PG8_BAR __builtin_amdgcn_s_barrier()
#define PG8_SCHED __builtin_amdgcn_sched_barrier(0)
    Unit cur, nxt; int ui = 0;
    if (!S.next(0, cur)) return;
    f32x4 acc[2][2][4][2];
#pragma unroll
    for (int a = 0; a < 2; ++a)
#pragma unroll
        for (int b = 0; b < 2; ++b)
#pragma unroll
            for (int m = 0; m < 4; ++m)
#pragma unroll
                for (int n = 0; n < 2; ++n) acc[a][b][m][n] = (f32x4){0.f, 0.f, 0.f, 0.f};
    bf16x8 At[4][2], B0[2][2], B1[2][2];
    const char* cA = (const char*)g.A + (size_t)cur.pm * tstep; const char* cB = (const char*)g.Bt + (size_t)cur.pn * tstep;
    constexpr bool HV = Sched::HALVES;
    size_t cah = hstep;
    if constexpr (HV) { if (cur.hm >= 0) { cah = 0; cA += (size_t)cur.hm * hstep; } }
    S.a_ready(cur); S.unit_begin(cur); if constexpr (Epi::HAS_BEGIN) E.begin(cur);
    if constexpr (SP2) {
        PG8_STAGE(PG8_SB(0, 0), cB, voffB); PG8_STAGE(PG8_SB(0, 1), cB + hstep, voffB); PG8_STAGE(PG8_SA(0, 0), cA, voffA); PG8_STAGE(PG8_SA(0, 1), cA + cah, voffA);
        if (wr == 1) PG8_BAR;
        PG8_WAIT_V(2); PG8_BAR;
        PG8_STAGE(PG8_SB(1, 0), cB + kstep, voffB); PG8_STAGE(PG8_SA(1, 0), cA + kstep, voffA); PG8_STAGE(PG8_SB(1, 1), cB + hstep + kstep, voffB);
        PG8_WAIT_V(6); PG8_BAR;
    } else {
        PG8_STAGE(PG8_SB(0, 0), cB, voffB); PG8_STAGE(PG8_SA(0, 0), cA, voffA); PG8_STAGE(PG8_SB(0, 1), cB + hstep, voffB); PG8_STAGE(PG8_SA(0, 1), cA + cah, voffA);
        if (wr == 1) PG8_BAR;
        PG8_WAIT_V(4); PG8_BAR;
        PG8_STAGE(PG8_SB(1, 0), cB + kstep, voffB); PG8_STAGE(PG8_SA(1, 0), cA + kstep, voffA); PG8_STAGE(PG8_SB(1, 1), cB + hstep + kstep, voffB);
        PG8_WAIT_V(6); PG8_BAR;
    }
    for (;;) {
        const bool has_next = S.next(ui + 1, nxt);
        const char* nA = has_next ? (const char*)g.A + (size_t)nxt.pm * tstep : cA; const char* nB = has_next ? (const char*)g.Bt + (size_t)nxt.pn * tstep : cB;
        size_t nah = has_next ? hstep : cah;
        if constexpr (HV) { if (has_next && nxt.hm >= 0) { nah = 0; nA += (size_t)nxt.hm * hstep; } }
        const bool full = !HV || cur.hm < 0;
        for (int t = 0; t < nt; t += 2) {
            const bool last = (t == nt - 2);
            if constexpr (Epi::MID > 0) { if (t == Epi::MID) E.mid(acc, wr, fr); }
            const char* a1 = cA + (size_t)(t + 1) * kstep;
            const char* a2 = last ? nA : cA + (size_t)(t + 2) * kstep; const char* b2 = last ? nB : cB + (size_t)(t + 2) * kstep;
            const char* a3 = a2 + kstep; const char* b3 = b2 + kstep;
            if (last && has_next) S.a_ready(nxt);
            if constexpr (SP2) {
            PG8_LDB(B0, 0, 0); PG8_LDB(B1, 0, 1); PG8_SCHED; PG8_LDA(At, 0, 0); PG8_STAGE(PG8_SA(1, 1), a1 + cah, voffA);
            PG8_WAIT_V(8); PG8_WAIT_L(0); PG8_BAR; PG8_MMA(0, 0, At, B0); PG8_MMA(0, 1, At, B1); PG8_BAR; PG8_SCHED;
            PG8_LDA(At, 0, 1); PG8_STAGE(PG8_SB(0, 0), b2, voffB); PG8_STAGE(PG8_SB(0, 1), b2 + hstep, voffB); PG8_STAGE(PG8_SA(0, 0), a2, voffA);
            PG8_WAIT_V(8); PG8_WAIT_L(0); PG8_BAR; if (full) { PG8_MMA(1, 0, At, B0); PG8_MMA(1, 1, At, B1); } PG8_BAR; PG8_SCHED;
            PG8_LDB(B0, 1, 0); PG8_LDB(B1, 1, 1); PG8_SCHED; PG8_LDA(At, 1, 0); PG8_STAGE(PG8_SA(0, 1), a2 + (last ? nah : cah), voffA);
            PG8_WAIT_V(8); PG8_WAIT_L(0); PG8_BAR; PG8_MMA(0, 0, At, B0); PG8_MMA(0, 1, At, B1); PG8_BAR; PG8_SCHED;
            PG8_LDA(At, 1, 1); PG8_STAGE(PG8_SB(1, 0), b3, voffB); PG8_STAGE(PG8_SB(1, 1), b3 + hstep, voffB); PG8_STAGE(PG8_SA(1, 0), a3, voffA);
            PG8_WAIT_V(8); PG8_WAIT_L(0); PG8_BAR; if (full) { PG8_MMA(1, 0, At, B0); PG8_MMA(1, 1, At, B1); } PG8_BAR; PG8_SCHED;
            } else {
            PG8_LDB(B0, 0, 0); PG8_SCHED; PG8_LDA(At, 0, 0); PG8_STAGE(PG8_SA(1, 1), a1 + hstep, voffA);
            PG8_WAIT_L(8); PG8_BAR; PG8_WAIT_L(0); PG8_MMA(0, 0, At, B0); PG8_BAR; PG8_SCHED;
            PG8_LDB(B1, 0, 1); PG8_STAGE(PG8_SB(0, 0), b2, voffB);
            PG8_BAR; PG8_WAIT_L(0); PG8_MMA(0, 1, At, B1); PG8_BAR;
            PG8_LDA(At, 0, 1); PG8_STAGE(PG8_SA(0, 0), a2, voffA);
            PG8_BAR; PG8_WAIT_L(0); PG8_MMA(1, 0, At, B0); PG8_BAR; PG8_SCHED;
            PG8_STAGE(PG8_SB(0, 1), b2 + hstep, voffB);
            PG8_WAIT_V(6); PG8_BAR; PG8_MMA(1, 1, At, B1); PG8_BAR;
            PG8_LDB(B0, 1, 0); PG8_SCHED; PG8_LDA(At, 1, 0); PG8_STAGE(PG8_SA(0, 1), a2 + hstep, voffA);
            PG8_WAIT_L(8); PG8_BAR; PG8_WAIT_L(0); PG8_MMA(0, 0, At, B0); PG8_BAR; PG8_SCHED;
            PG8_LDB(B1, 1, 1); PG8_STAGE(PG8_SB(1, 0), b3, voffB);
            PG8_BAR; PG8_WAIT_L(0); PG8_MMA(0, 1, At, B1); PG8_BAR;
            PG8_LDA(At, 1, 1); PG8_STAGE(PG8_SA(1, 0), a3, voffA);
            PG8_BAR; PG8_WAIT_L(0); PG8_MMA(1, 0, At, B0); PG8_BAR; PG8_SCHED;
            PG8_STAGE(PG8_SB(1, 1), b3 + hstep, voffB);
            PG8_WAIT_V(6); PG8_BAR; PG8_MMA(1, 1, At, B1); PG8_BAR;
            }
        }
        if constexpr (ALIGN_EPI) { if (wr == 0) PG8_BAR; }
        if constexpr (!Epi::AFTER_DRAIN) { E(acc, cur, wr, wc, fr, fq); if (MK_EPI_DRAIN) { PG8_WAIT_V(0); } S.done(cur); }
        if (!has_next) break;
        S.unit_begin(nxt); if constexpr (Epi::HAS_BEGIN) E.begin(nxt);
#pragma unroll
        for (int a = 0; a < 2; ++a)
#pragma unroll
            for (int b = 0; b < 2; ++b)
#pragma unroll
                for (int m = 0; m < 4; ++m)
#pragma unroll
                    for (int n = 0; n < 2; ++n) acc[a][b][m][n] = (f32x4){0.f, 0.f, 0.f, 0.f};
        cur = nxt; cA = nA; cB = nB; cah = nah; ++ui;
        if constexpr (ALIGN_EPI) { if (wr == 1) PG8_BAR; }
    }
    PG8_WAIT_V(0);
    if constexpr (!ALIGN_EPI) { if (wr == 0) PG8_BAR; }
    PG8_BAR;
    if constexpr (Epi::AFTER_DRAIN) { E.fused(acc, cur, wr, wc, fr, fq, lds, wid, lane); S.done(cur); }
#undef PG8_SA
#undef PG8_SB
#undef PG8_STAGE
#undef PG8_LDA
#undef PG8_LDB
#undef PG8_MMA
#undef PG8_WAIT_V
#undef PG8_WAIT_L
#undef PG8_BAR
#undef PG8_SCHED
}
}
#define GAS __attribute__((address_space(1)))
#define LAS __attribute__((address_space(3)))
typedef unsigned short bf16;
typedef unsigned v4u __attribute__((ext_vector_type(4)));
typedef float f32x4 __attribute__((ext_vector_type(4)));
typedef short bf16x8 __attribute__((ext_vector_type(8)));
typedef GAS unsigned gu32;
typedef GAS unsigned long long gu64;
#define RLX_AGENT __ATOMIC_RELAXED, __HIP_MEMORY_SCOPE_AGENT
#define LDS_WAIT() asm volatile("s_waitcnt lgkmcnt(0)" ::: "memory")
#define VM_WAIT() asm volatile("s_waitcnt vmcnt(0)" ::: "memory")
__device__ __forceinline__ unsigned long long rt() { return __builtin_amdgcn_s_memrealtime(); }
__device__ __forceinline__ unsigned f2bf(float f) { unsigned u = __builtin_bit_cast(unsigned, f); return (u + 0x7fffu + ((u >> 16) & 1u)) >> 16; }
__device__ __forceinline__ unsigned pk2(float lo, float hi) { return f2bf(lo) | (f2bf(hi) << 16); }

#define XB_TMO      128
#define XB_XCNT(j)  (256  + 64 * (j))
#define XB_XSUB(j)  (1280 + 64 * (j))
#define XB_XGEN(j)  (2304 + 64 * (j))
#define XB_TOP      3328
#define XB_TOPGEN   3392
#define XCD_BAR_WORDS 3456
#define XB_SPIN_CAP (1u << 18)

__device__ __forceinline__ unsigned xb_ld(unsigned* p)              { return __hip_atomic_load(p, __ATOMIC_RELAXED, __HIP_MEMORY_SCOPE_AGENT); }
__device__ __forceinline__ unsigned xb_add(unsigned* p, unsigned v) { return __hip_atomic_fetch_add(p, v, __ATOMIC_RELAXED, __HIP_MEMORY_SCOPE_AGENT); }
__device__ __forceinline__ unsigned xb_xcc_id() { return (unsigned)__builtin_amdgcn_s_getreg((3 << 11) | 20) & 0xFu; }
#define XB_SPIN(cond, bar) do { unsigned _sp = 0; while (cond) { __builtin_amdgcn_s_sleep(1); \
    if ((++_sp & 255u) == 0u) { if (xb_ld(&(bar)[XB_TMO])) break; if (_sp > XB_SPIN_CAP) { atomicAdd(&(bar)[XB_TMO], 1u); break; } } } } while (0)

struct XcdBarrier {
    unsigned* bar; unsigned x;
    volatile LAS unsigned* st;
};

__device__ __forceinline__ XcdBarrier xcd_barrier_post(unsigned* bar, volatile LAS unsigned* st) {
    XcdBarrier b; b.bar = bar; b.x = xb_xcc_id(); b.st = st;
    if (threadIdx.x == 0) (void)xb_add(&bar[XB_XCNT(b.x)], 1u);
    return b;
}
__device__ __forceinline__ void xcd_barrier_complete(unsigned* bar, unsigned x, unsigned& nloc, unsigned& nx) {
    const unsigned G = gridDim.x * gridDim.y * gridDim.z;
    unsigned sum, cnt, mine, sp = 0u;
    for (;;) {
        sum = 0u; cnt = 0u; mine = 0u;
#pragma unroll
        for (unsigned j = 0; j < 16; ++j) { const unsigned c = xb_ld(&bar[XB_XCNT(j)]); sum += c; cnt += (c > 0u) ? 1u : 0u; mine = (j == x) ? c : mine; }
        if (sum == G) break;
        __builtin_amdgcn_s_sleep(1);
        if ((++sp & 255u) == 0u) { if (xb_ld(&bar[XB_TMO])) break; if (sp > XB_SPIN_CAP) { atomicAdd(&bar[XB_TMO], 1u); break; } }
    }
    nloc = mine > 0u ? mine : 1u; nx = cnt > 0u ? cnt : 1u;
}

__device__ __forceinline__ void xcd_barrier(const XcdBarrier& b) {
    asm volatile("s_waitcnt vmcnt(0)" ::: "memory");
    __syncthreads();
    if (threadIdx.x == 0) {
        unsigned* bar = b.bar;
        __builtin_amdgcn_s_waitcnt(0);
        unsigned nloc = b.st[0], nx = b.st[1];
        if (nloc == 0u) { xcd_barrier_complete(bar, b.x, nloc, nx); b.st[0] = nloc; b.st[1] = nx; }
        const unsigned old = xb_add(&bar[XB_XSUB(b.x)], 1u);
        const unsigned gen = old / nloc;
        if (old + 1u == (gen + 1u) * nloc) {
            __builtin_amdgcn_fence(__ATOMIC_RELEASE, "agent");
            asm volatile("s_waitcnt vmcnt(0)" ::: "memory");
            const unsigned og = xb_add(&bar[XB_TOP], 1u);
            const unsigned tg = og / nx;
            if (og + 1u == (tg + 1u) * nx) xb_add(&bar[XB_TOPGEN], 1u);
            else XB_SPIN(xb_ld(&bar[XB_TOPGEN]) == tg, bar);
            __builtin_amdgcn_fence(__ATOMIC_ACQUIRE, "agent");
            xb_add(&bar[XB_XGEN(b.x)], 1u);
            asm volatile("s_waitcnt vmcnt(0)" ::: "memory");
        } else {
            XB_SPIN(xb_ld(&bar[XB_XGEN(b.x)]) == gen, bar);
            __builtin_amdgcn_fence(__ATOMIC_ACQUIRE, "agent");
            asm volatile("s_waitcnt vmcnt(0)" ::: "memory");
        }
    }
    __syncthreads();
}

__device__ __forceinline__ void xcd_barrier_local(const XcdBarrier& b) {
    asm volatile("s_waitcnt vmcnt(0)" ::: "memory");
    __syncthreads();
    if (threadIdx.x == 0) {
        unsigned* bar = b.bar;
        __builtin_amdgcn_s_waitcnt(0);
        unsigned nloc = b.st[0], nx = b.st[1];
        if (nloc == 0u) { xcd_barrier_complete(bar, b.x, nloc, nx); b.st[0] = nloc; b.st[1] = nx; }
        const unsigned old = xb_add(&bar[XB_XSUB(b.x)], 1u);
        const unsigned gen = old / nloc;
        if (old + 1u == (gen + 1u) * nloc) xb_add(&bar[XB_XGEN(b.x)], 1u);
        else XB_SPIN(xb_ld(&bar[XB_XGEN(b.x)]) == gen, bar);
        __builtin_amdgcn_fence(__ATOMIC_ACQUIRE, "agent");
        asm volatile("s_waitcnt vmcnt(0)" ::: "memory");
    }
    __syncthreads();
}

#ifndef MK_FUSE5
#define MK_FUSE5 1
#endif
#ifndef MK_HALVES
#define MK_HALVES 1
#endif
#ifndef MK_PAQ
#define MK_PAQ 0
#endif
#ifndef MK_EPI3
#define MK_EPI3 1
#endif
#ifndef MK_LIGHT
#define MK_LIGHT 1
#endif
#ifndef MK_CTXB
#define MK_CTXB 1
#endif
#ifndef MK_TQ
#define MK_TQ 1
#endif
#ifndef MK_ATTX
#define MK_ATTX 1
#endif
#ifndef MK_NANPOISON
#define MK_NANPOISON 0
#endif
#ifndef MK_NOASM
#define MK_NOASM 0
#endif
#ifndef MK_DIAG_RAWY
#define MK_DIAG_RAWY 0
#endif
constexpr int NWAVES = 8;
constexpr int DM = 1024, NCTX = 4096, NLAT = 16384, NTOK = 20480, INW = 1280, DFF = 2816, UPW = 5632;
constexpr float RMS_EPS = 1e-6f;
constexpr float LOG2E = 1.4426950408889634f;
constexpr float QSCALE = 0.125f * LOG2E;
constexpr int NSEG = 160;

constexpr size_t MiB = 1u << 20;
constexpr size_t WS_CTL = 0, CTL_ZERO_BYTES = 1 * MiB;
constexpr size_t WS_MOD = 1 * MiB;
constexpr size_t WS_ROPE = 1 * MiB + 128 * 1024;
constexpr size_t WS_SSMC = 1 * MiB + 256 * 1024;
constexpr size_t WS_SSMG = 2 * MiB + 256 * 1024;
constexpr size_t WS_ESEG = 190 * MiB;
constexpr size_t WS_CTXK = 8 * MiB, WS_CTXVT = 8 * MiB + 512 * 1024;
constexpr size_t WS_SB = 9 * MiB;
constexpr size_t WS_WIN = 16 * MiB, WS_WOUT = 19 * MiB, WS_WUP = 21 * MiB, WS_WDN = 32 * MiB;
constexpr size_t WS_XN = 38 * MiB;
constexpr size_t WS_R = 78 * MiB;
constexpr size_t WS_Q = WS_R, WS_K = WS_R + 20 * MiB, WS_VT = WS_R + 25 * MiB, WS_U = WS_R + 30 * MiB, WS_SS = WS_R + 50 * MiB, WS_AO = 200 * MiB;
constexpr size_t WS_PS = 240 * MiB;
constexpr size_t WS_ACT = WS_R;
constexpr size_t WS_END = 244 * MiB;
constexpr int CW_BAR = 4096, CW_RANK = 65536, CW_TCNT = 98304, CW_PAQ = 131072, CW_TQ = 140000;
constexpr int CW_BAR_ = 0;

constexpr int RING_OFF = 0, RING_BYTES = 131072;
constexpr int LDSCTL_OFF = RING_BYTES, MISC_OFF = LDSCTL_OFF + 320;
constexpr int XBUF_OFF = RING_BYTES + 1024;
constexpr int CWL_OFF = XBUF_OFF + 10240;
constexpr int LDS_BYTES = 147456;

typedef short bf16x4 __attribute__((ext_vector_type(4)));
typedef float f32x16 __attribute__((ext_vector_type(16)));
typedef unsigned u32x2 __attribute__((ext_vector_type(2)));
typedef float f32x2t __attribute__((ext_vector_type(2)));
typedef __bf16 bf16x2t __attribute__((ext_vector_type(2)));
__device__ __forceinline__ unsigned cvtpk(float lo, float hi) { f32x2t v = {lo, hi}; bf16x2t b = __builtin_convertvector(v, bf16x2t); return __builtin_bit_cast(unsigned, b); }
__device__ __forceinline__ float bf2f(unsigned short h) { return __builtin_bit_cast(float, (unsigned)h << 16); }
__device__ __forceinline__ float sum_x16(float v) { const auto r = __builtin_amdgcn_permlane16_swap(__float_as_uint(v), __float_as_uint(v), false, false); return __uint_as_float(r[0]) + __uint_as_float(r[1]); }
__device__ __forceinline__ float sum_x32(float v) { const auto r = __builtin_amdgcn_permlane32_swap(__float_as_uint(v), __float_as_uint(v), false, false); return __uint_as_float(r[0]) + __uint_as_float(r[1]); }
__device__ __forceinline__ float max_x32(float v) { const auto r = __builtin_amdgcn_permlane32_swap(__float_as_uint(v), __float_as_uint(v), false, false); return fmaxf(__uint_as_float(r[0]), __uint_as_float(r[1])); }
__device__ __forceinline__ float wave_sum(float v) {
    v += __int_as_float(__builtin_amdgcn_update_dpp(0, __float_as_int(v), 0xB1, 0xF, 0xF, true));
    v += __int_as_float(__builtin_amdgcn_update_dpp(0, __float_as_int(v), 0x4E, 0xF, 0xF, true));
    v += __int_as_float(__builtin_amdgcn_update_dpp(0, __float_as_int(v), 0x141, 0xF, 0xF, true));
    v += __int_as_float(__builtin_amdgcn_update_dpp(0, __float_as_int(v), 0x140, 0xF, 0xF, true));
    return sum_x32(sum_x16(v));
}
__device__ __forceinline__ float fast_sigmoid(float x) { return __builtin_amdgcn_rcpf(1.f + __builtin_amdgcn_exp2f(-x * LOG2E)); }
__device__ __forceinline__ float siluf(float x) { return x * fast_sigmoid(x); }
__device__ __forceinline__ float gelu_tanh(float x) { const float u = 0.7978845608028654f * (x + 0.044715f * x * x * x); return x * fast_sigmoid(2.f * u); }

struct Args {
    const float *x_prompt, *x_sample, *cache_k, *cache_v, *st_re, *st_im, *c, *c_ctx, *w_ada, *b_ada, *g_norm1, *g_norm2, *w_in, *sink;
    const float *lam_re, *lam_im, *log_dt, *b_re, *b_im, *c_re, *c_im, *ssm_d, *wglu, *g_attn, *g_ssm, *w_out, *w_up, *conv_w, *conv_b, *w_down, *g_final;
    float* out; unsigned char* ws; int ph_lo, ph_hi, li, pad;
};

struct Frame {
    LAS unsigned char* lds; volatile LAS unsigned* MISC; gu32* ctl;
    int tid, lane, wave, G;
    int xo, nx, rank, nloc;
};
template <bool HV> struct XcdOrderT {
    static constexpr bool HALVES = HV;
    int nN, npm, nx, xo, rank, nloc, mmajor; unsigned* cnt; const float* ps; LAS float* rs; int R, lo; bool hs; int rot, cpn;
    __device__ __forceinline__ void init(int M, int N, const Frame& F, int mmajor_ = 0, unsigned* cnt_ = nullptr) { nN = N / 256; nx = F.nx; xo = F.xo; rank = F.rank; nloc = F.nloc; mmajor = mmajor_; cnt = cnt_; ps = nullptr; rs = nullptr; rot = 0; cpn = 0; const int nM = M / 256; npm = xo < nM ? (nM - xo + nx - 1) / nx : 0;
        const int tot = npm * nN; R = tot / nloc; lo = tot - R * nloc; hs = HV && lo > 0 && 2 * lo <= nloc; }
    __device__ __forceinline__ bool next(int i, pg8::Unit& u) const { int j = i * nloc + rank; u.hm = -1;
        if (hs && i >= R) { if (i > R || rank >= 2 * lo) return false; j = R * nloc + (rank >> 1); u.hm = rank & 1; }
        else if (j >= npm * nN) return false;
        if (mmajor) { u.pm = xo + nx * (j / nN); u.pn = j % nN; } else { u.pm = xo + nx * (j % npm); u.pn = j / npm + rot; if (u.pn >= nN) u.pn -= nN; } return true; }
    __device__ __forceinline__ void a_ready(const pg8::Unit&) const {}
    __device__ __forceinline__ void unit_begin(const pg8::Unit& u) const {
        if (ps) { const int t = threadIdx.x; const f32x4* p = (const f32x4*)(ps + ((size_t)(u.pm * 256 + (t >> 1))) * 32 + 16 * (t & 1));
            const f32x4 a0 = p[0], a1 = p[1], a2 = p[2], a3 = p[3];
            float sq = ((a0.x + a0.y) + (a0.z + a0.w)) + ((a1.x + a1.y) + (a1.z + a1.w)) + (((a2.x + a2.y) + (a2.z + a2.w)) + ((a3.x + a3.y) + (a3.z + a3.w)));
            sq += __int_as_float(__builtin_amdgcn_update_dpp(0, __float_as_int(sq), 0xB1, 0xF, 0xF, true));
            if (!(t & 1)) rs[t >> 1] = rsqrtf(sq * (1.f / 512.f) + RMS_EPS); }
    }
    __device__ __forceinline__ void done(const pg8::Unit& u) const {
        if (cnt && u.pn >= cpn) { asm volatile("s_waitcnt vmcnt(0) lgkmcnt(0)" ::: "memory"); __builtin_amdgcn_s_barrier(); asm volatile("" ::: "memory");
            if (threadIdx.x == 0) __hip_atomic_fetch_add(cnt + 64 * u.pm, u.hm < 0 ? 2u : 1u, __ATOMIC_RELAXED, __HIP_MEMORY_SCOPE_AGENT); }
    }
};
typedef XcdOrderT<false> XcdOrder;
__device__ __forceinline__ void tiles_wait(Frame& F, unsigned* cnt, int lt0, int lt1, unsigned need) {
    if (F.tid == 0) {
        unsigned sp = 0;
        for (int lt = lt0; lt < lt1; ++lt) { const int pm = F.xo + F.nx * lt;
            while (__hip_atomic_load(cnt + 64 * pm, __ATOMIC_RELAXED, __HIP_MEMORY_SCOPE_AGENT) < need) { __builtin_amdgcn_s_sleep(8); if (++sp > (1u << 22)) { __hip_atomic_store((unsigned*)F.ctl + 2, 0xDEADu, __ATOMIC_RELAXED, __HIP_MEMORY_SCOPE_AGENT); break; } } }
        __builtin_amdgcn_fence(__ATOMIC_ACQUIRE, "agent");
        asm volatile("s_waitcnt vmcnt(0)" ::: "memory");
    }
    __syncthreads();
}
#define ROWS_AFFINE_BEGIN(F, row, cnt, nN_, HS_) { const int npm_ = (F).xo < 80 ? (80 - (F).xo + (F).nx - 1) / (F).nx : 0; \
    const int tot_ = npm_ * (nN_), lo0_ = tot_ % (F).nloc, lo_ = (cnt) ? (((HS_) && lo0_ > 0 && 2 * lo0_ <= (F).nloc) ? 2 * lo0_ : lo0_) : 0, ne_ = (cnt) ? ((tot_ / (F).nloc) * (F).nloc) / (nN_) : npm_; \
    const bool part_ = !(cnt) || lo_ == 0 || (F).nloc - lo_ < 4; const int w0_ = part_ ? 0 : lo_, nw_ = (F).nloc - w0_; \
    if ((F).rank >= w0_) for (int grp_ = 0; grp_ < 2; ++grp_) { const int lt0_ = grp_ ? ne_ : 0, lt1_ = grp_ ? npm_ : ne_; if (lt0_ >= lt1_) continue; \
        if (cnt) tiles_wait(F, cnt, lt0_, lt1_, (unsigned)(2 * (nN_))); \
        for (int lt_ = lt0_; lt_ < lt1_; ++lt_) for (int r_ = ((F).rank - w0_) * NWAVES + (F).wave; r_ < 256; r_ += 2 * nw_ * NWAVES) { const int row = ((F).xo + (F).nx * lt_) * 256 + r_; \
            const bool has2 = r_ + nw_ * NWAVES < 256; const int row2 = has2 ? row + nw_ * NWAVES : row;
#define ROWS_AFFINE_END } } }

__device__ __forceinline__ void transpose_item(const float* W, int K, int N, bf16* WT, int k0, int n0, int dst_row0, LAS float* scr, int lane, int kdst = -1, const float* ksc = nullptr) {
    if (kdst < 0) kdst = k0;
    LAS unsigned* s32 = (LAS unsigned*)scr;
    const int r = lane >> 3, c4 = lane & 7;
    const float* wp = W + (size_t)(k0 + 2 * r) * N + n0 + 4 * c4;
    f32x4 v[4][2];
#pragma unroll
    for (int i = 0; i < 4; ++i) { v[i][0] = *(const f32x4*)(wp + (size_t)(16 * i) * N); v[i][1] = *(const f32x4*)(wp + (size_t)(16 * i + 1) * N); }
    if (ksc) {
#pragma unroll
        for (int i = 0; i < 4; ++i) { v[i][0] = v[i][0] * ksc[16 * i + 2 * r]; v[i][1] = v[i][1] * ksc[16 * i + 2 * r + 1]; } }
#pragma unroll
    for (int i = 0; i < 4; ++i) { LAS unsigned* d = s32 + (4 * c4) * 33 + 8 * i + r;
        d[0 * 33] = pk2(v[i][0].x, v[i][1].x); d[1 * 33] = pk2(v[i][0].y, v[i][1].y); d[2 * 33] = pk2(v[i][0].z, v[i][1].z); d[3 * 33] = pk2(v[i][0].w, v[i][1].w); }
    LDS_WAIT(); asm volatile("" ::: "memory");
    const int c = lane & 7;
#pragma unroll
    for (int j = 0; j < 4; ++j) { const int n = (lane >> 3) + 8 * j; const LAS unsigned* s = s32 + n * 33 + 4 * c;
        v4u o; o.x = s[0]; o.y = s[1]; o.z = s[2]; o.w = s[3];
        *(GAS v4u*)(WT + (size_t)(dst_row0 + n) * K + kdst + 8 * c) = o; }
    LDS_WAIT(); asm volatile("" ::: "memory");
}

__device__ __forceinline__ void wout_item(const Args& a, int r, LAS float* scr, int lane) {
    const int kb = r / 32, nb = r % 32;
    if (MK_FUSE5) transpose_item(a.w_out, 1024, 1024, (bf16*)(a.ws + WS_WOUT), 64 * kb, 32 * nb, 32 * nb, scr, lane, (64 * kb + 512) & 1023, kb >= 8 ? a.g_ssm + 64 * (kb - 8) : nullptr);
    else transpose_item(a.w_out, 1024, 1024, (bf16*)(a.ws + WS_WOUT), 64 * kb, 32 * nb, 32 * nb, scr, lane);
}
__device__ __forceinline__ void updn_item(const Args& a, int r, LAS float* scr, int lane) {
    unsigned char* ws = a.ws;
    if (r < 16 * 32) { wout_item(a, r, scr, lane); return; }
    r -= 16 * 32;
    if (r < 16 * 176) { const int kb = r / 176, nb = r % 176; const int n0 = 32 * nb; const int half = n0 >= DFF ? 1 : 0; const int f = n0 - half * DFF;
        transpose_item(a.w_up, 1024, UPW, (bf16*)(ws + WS_WUP), 64 * kb, n0, 256 * (f >> 7) + 128 * half + (f & 127), scr, lane); return; }
    r -= 16 * 176;
    { const int kb = r / 32, nb = r % 32; transpose_item(a.w_down, DFF, 1024, (bf16*)(ws + WS_WDN), 64 * kb, 32 * nb, 32 * nb, scr, lane); }
}
__device__ __forceinline__ void transpose_queue(Frame& F, const Args& a) {
    constexpr int NQ = 16 * 32 + 16 * 176 + 44 * 32;
    unsigned* head = (unsigned*)F.ctl + CW_TQ;
    volatile LAS unsigned* slot = F.MISC + 44;
    LAS float* scr = (LAS float*)(F.lds + RING_OFF + F.wave * 16384);
    unsigned kn = 0;
    if (F.tid == 0) kn = __hip_atomic_fetch_add(head, 8u, __ATOMIC_RELAXED, __HIP_MEMORY_SCOPE_AGENT);
    for (int it = 0; ; ++it) {
        if (F.tid == 0) { slot[it & 1] = kn; kn = __hip_atomic_fetch_add(head, 8u, __ATOMIC_RELAXED, __HIP_MEMORY_SCOPE_AGENT); }
        __syncthreads();
        const unsigned k0 = slot[it & 1];
        if (k0 >= (unsigned)NQ) break;
        const unsigned k = k0 + (unsigned)F.wave;
        if (k < (unsigned)NQ) updn_item(a, (int)k, scr, F.lane);
    }
}

constexpr int ADA_UNITS = 192;
__device__ __forceinline__ void p0_setup(Frame& F, const Args& a) {
    unsigned char* ws = a.ws;
    float* MOD = (float*)(ws + WS_MOD);
    LAS float* ldsf = (LAS float*)F.lds;
    for (int u = blockIdx.x; u < ADA_UNITS; u += F.G) {
        LAS float* scond = ldsf; LAS float* red = ldsf + 5120;
        for (int i = F.tid; i < 5120; i += 512) { const int r = i >> 10, k = i & 1023; const float v = (r == 0) ? a.c_ctx[k] : a.c[(r - 1) * 1024 + k]; scond[i] = v / (1.f + __expf(-v)); }
        __syncthreads();
        const int n0 = u * 32, rg = F.lane >> 3, c4 = F.lane & 7;
        float acc[5][4];
#pragma unroll
        for (int r = 0; r < 5; ++r)
#pragma unroll
            for (int j = 0; j < 4; ++j) acc[r][j] = 0.f;
        const float* wp = a.w_ada + (size_t)(F.wave * 128 + rg) * 6144 + n0 + 4 * c4;
#pragma unroll 8
        for (int i = 0; i < 16; ++i) {
            const f32x4 w = *(const f32x4*)(wp + (size_t)i * 8 * 6144);
            const int k = F.wave * 128 + 8 * i + rg;
#pragma unroll
            for (int r = 0; r < 5; ++r) { const float s = scond[r * 1024 + k]; acc[r][0] += s * w.x; acc[r][1] += s * w.y; acc[r][2] += s * w.z; acc[r][3] += s * w.w; }
        }
#pragma unroll
        for (int r = 0; r < 5; ++r)
#pragma unroll
            for (int j = 0; j < 4; ++j) { float v = acc[r][j]; v += __int_as_float(__builtin_amdgcn_update_dpp(0, __float_as_int(v), 0x128, 0xF, 0xF, true));
                acc[r][j] = sum_x32(sum_x16(v)); }
        if (rg == 0) {
#pragma unroll
            for (int r = 0; r < 5; ++r)
#pragma unroll
                for (int j = 0; j < 4; ++j) red[(F.wave * 5 + r) * 32 + 4 * c4 + j] = acc[r][j];
        }
        __syncthreads();
        if (F.tid < 160) { const int r = F.tid >> 5, cc = F.tid & 31; float s = a.b_ada[n0 + cc];
#pragma unroll
            for (int w = 0; w < 8; ++w) s += red[(w * 5 + r) * 32 + cc];
            MOD[r * 6144 + n0 + cc] = s; }
        __syncthreads();
    }
    __syncthreads();
    {
        LAS float* scr = (LAS float*)(F.lds + RING_OFF + F.wave * 16384);
        const int gw = (int)blockIdx.x * NWAVES + F.wave, NGW = F.G * NWAVES;
        constexpr int I_IN = 16 * 40, I_OUT = 16 * 32, I_UP = 16 * 176, I_DN = 44 * 32;
        constexpr int NITEMS = MK_TQ ? I_IN : I_IN + I_OUT + I_UP + I_DN;
        const int npoor = F.G > ADA_UNITS ? ADA_UNITS * NWAVES : 0, nrich = NGW - npoor;
        const bool rich = gw >= npoor; const int wi = rich ? gw - npoor : gw;
        const int rich_items = nrich * 3 < NITEMS ? nrich * 3 : NITEMS;
        const int nbase = rich ? 3 : 2, poor_end = rich_items + 2 * npoor < NITEMS ? rich_items + 2 * npoor : NITEMS;
        for (int q = 0; ; ++q) {
            int it;
            if (q < nbase) { it = rich ? wi + q * nrich : rich_items + wi + q * npoor; if (it >= (rich ? rich_items : poor_end)) continue; }
            else { it = poor_end + (q - nbase) * NGW + gw; if (it >= NITEMS) break; }
            int r = it;
            if (r < I_IN) { const int kb = r / 40, nb = r % 40; transpose_item(a.w_in, 1024, 1280, (bf16*)(ws + WS_WIN), 64 * kb, 32 * nb, 32 * nb, scr, F.lane); continue; } r -= I_IN;
            if (!MK_TQ) { if (r < I_OUT) { wout_item(a, r, scr, F.lane); continue; } r -= I_OUT; }
            if (r < I_UP) { const int kb = r / 176, nb = r % 176; const int n0 = 32 * nb; const int half = n0 >= DFF ? 1 : 0; const int f = n0 - half * DFF;
                transpose_item(a.w_up, 1024, UPW, (bf16*)(ws + WS_WUP), 64 * kb, n0, 256 * (f >> 7) + 128 * half + (f & 127), scr, F.lane); continue; } r -= I_UP;
            { const int kb = r / 32, nb = r % 32; transpose_item(a.w_down, DFF, 1024, (bf16*)(ws + WS_WDN), 64 * kb, 32 * nb, 32 * nb, scr, F.lane); }
        }
    }
    {
        const int gt = ((int)blockIdx.x * NWAVES + F.wave) * 64 + F.lane, NGT = F.G * NWAVES * 64;
        float* RC = (float*)(ws + WS_ROPE); float* RS = RC + 1024;
        for (int i = gt; i < 1024; i += NGT) { const int pos = i >> 4, fi = i & 15; const float ang = (float)pos * powf(10000.f, -(float)fi / 16.f); RC[i] = cosf(ang); RS[i] = sinf(ang); }
        bf16* CK = (bf16*)(ws + WS_CTXK); bf16* CVT = (bf16*)(ws + WS_CTXVT);
        for (int i = gt; i < 4 * 512 * 128; i += NGT) {
            CK[i] = (bf16)f2bf(a.cache_k[i]);
            const int t = i & 511, d = (i >> 9) & 63, kvh = (i >> 15) & 1, b = i >> 16;
            CVT[i] = (bf16)f2bf(a.cache_v[((size_t)(b * 512 + t) * 2 + kvh) * 64 + d]);
        }
        const int gw = (int)blockIdx.x * NWAVES + F.wave, NGW = F.G * NWAVES;
        const int task = gw - (NGW - 64);
        if (task >= 0) {
            const int gi = task, g = gi & 31, n = F.lane;
            const float lr = a.lam_re[gi * 64 + n], li = a.lam_im[gi * 64 + n], dt = expf(a.log_dt[gi]);
            const float mag = expf(lr * dt), ang = li * dt, a_re = mag * cosf(ang), a_im = mag * sinf(ang);
            const float den = lr * lr + li * li, nr = a_re - 1.f;
            const float cf_re = (nr * lr + a_im * li) / den, cf_im = (a_im * lr - nr * li) / den;
            unsigned char* base = ws + WS_SSMC + (size_t)gi * 16384;
            bf16* BBm = (bf16*)base; bf16* CM = (bf16*)(base + 4096); float* AP = (float*)(base + 8192);
            const int c = n & 31, hi = n >> 5;
            for (int p = 0; p < 16; ++p) {
                const float br = a.b_re[(size_t)(gi * 64 + n) * 16 + p], bi = a.b_im[(size_t)(gi * 64 + n) * 16 + p];
                BBm[((2 * hi) * 32 + c) * 16 + p] = (bf16)f2bf(cf_re * br - cf_im * bi);
                BBm[((2 * hi + 1) * 32 + c) * 16 + p] = (bf16)f2bf(cf_re * bi + cf_im * br);
                CM[p * 128 + 4 * c + 2 * hi] = (bf16)f2bf(a.c_re[(size_t)(gi * 16 + p) * 64 + n]);
                CM[p * 128 + 4 * c + 2 * hi + 1] = (bf16)f2bf(-a.c_im[(size_t)(gi * 16 + p) * 64 + n]);
            }
            AP[n] = a_re; AP[64 + n] = a_im;
            { const float m64 = expf(lr * dt * 64.f), g64 = li * dt * 64.f; AP[128 + n] = m64 * cosf(g64); AP[192 + n] = m64 * sinf(g64); }
            { const float m128 = expf(lr * dt * 128.f), g128 = li * dt * 128.f; AP[256 + n] = m128 * cosf(g128); AP[320 + n] = m128 * sinf(g128); }
            if (gi < 32) {
                unsigned char* gb = ws + WS_SSMG + (size_t)g * 1024; bf16* WgT = (bf16*)gb; float* dd = (float*)(gb + 512);
                for (int e = n; e < 256; e += 64) { const int q = e >> 4, p = e & 15; WgT[q * 16 + p] = (bf16)f2bf(a.wglu[(g * 16 + p) * 16 + q]); }
                if (n < 16) dd[n] = a.ssm_d[g * 16 + n];
            }
        }
    }
}

__device__ __forceinline__ int row_cls(int row) { return row < NCTX ? 0 : 1 + ((row - NCTX) >> 12); }
__device__ __forceinline__ void p_modulate(Frame& F, const Args& a, int which, unsigned* cnt = nullptr) {
    const float* MOD = (const float*)(a.ws + WS_MOD);
    const float* gn = which ? a.g_norm2 : a.g_norm1;
    const int sh_off = which ? 3072 : 0, sc_off = which ? 4096 : 1024;
    bf16* XN = (bf16*)(a.ws + WS_XN);
    ROWS_AFFINE_BEGIN(F, row, cnt, 4, 0) {
        int rw[2] = {row, row2};
        f32x4 v[2][4]; float s[2] = {0.f, 0.f};
#pragma unroll
        for (int q = 0; q < 2; ++q) { const int rr = rw[q];
            const float* xr = which ? a.out + (size_t)rr * DM : (rr < NCTX ? a.x_prompt + (size_t)rr * DM : a.x_sample + (size_t)(rr - NCTX) * DM);
#pragma unroll
            for (int j = 0; j < 4; ++j) v[q][j] = *(const f32x4*)(xr + 4 * F.lane + 256 * j); }
#pragma unroll
        for (int q = 0; q < 2; ++q)
#pragma unroll
            for (int j = 0; j < 4; ++j) s[q] += (v[q][j].x * v[q][j].x + v[q][j].y * v[q][j].y) + (v[q][j].z * v[q][j].z + v[q][j].w * v[q][j].w);
        const int cls = row_cls(row);
#pragma unroll
        for (int q = 0; q < 2; ++q) { if (q == 1 && !has2) break;
            const float rstd = rsqrtf(wave_sum(s[q]) * (1.f / DM) + RMS_EPS);
#pragma unroll
            for (int j = 0; j < 4; ++j) { const int c = 4 * F.lane + 256 * j;
                const f32x4 g = *(const f32x4*)(gn + c), sc = *(const f32x4*)(MOD + cls * 6144 + sc_off + c), sh = *(const f32x4*)(MOD + cls * 6144 + sh_off + c);
                const f32x4 o = v[q][j] * rstd * g * (sc + 1.f) + sh;
                u32x2 w; w.x = cvtpk(o.x, o.y); w.y = cvtpk(o.z, o.w);
                *(u32x2*)(XN + (size_t)rw[q] * DM + c) = w; } }
    } ROWS_AFFINE_END
}

struct EpiInProj {
    static constexpr bool PERM = false, AFTER_DRAIN = false, HAS_BEGIN = false; static constexpr int MID = 0;
    bf16 *Q, *Kb, *VT, *U; float *ok, *ov; const float *RC, *RS;
    __device__ __forceinline__ void operator()(const f32x4 (&acc)[2][2][4][2], const pg8::Unit& u, int wr, int wc, int fr, int fq) const {
        const int rowt = u.pm * 256; const bool latent = rowt >= NCTX; const int half = wc & 1;
#pragma unroll
        for (int ai = 0; ai < 2; ++ai)
#pragma unroll
            for (int m = 0; m < 4; ++m) {
                const int row = rowt + ai * 128 + wr * 64 + m * 16 + fr;
                f32x4 cs = {1.f, 1.f, 1.f, 1.f}, sn = {0.f, 0.f, 0.f, 0.f};
                if (latent && u.pn <= 2) { const int t = (row - NCTX) & 4095; const int pos = half ? (t & 63) : (t >> 6); cs = *(const f32x4*)(RC + pos * 16 + 4 * fq); sn = *(const f32x4*)(RS + pos * 16 + 4 * fq); }
#pragma unroll
                for (int bj = 0; bj < 2; ++bj) {
                    const f32x4 v0 = acc[ai][bj][m][0], v1 = acc[ai][bj][m][1];
                    if (u.pn < 2) {
                        const f32x4 r0 = (v0 * cs - v1 * sn) * QSCALE, r1 = (v0 * sn + v1 * cs) * QSCALE;
                        bf16* p = Q + (size_t)row * 512 + u.pn * 256 + bj * 128 + wc * 32 + 4 * fq;
                        u32x2 w0, w1; w0.x = cvtpk(r0.x, r0.y); w0.y = cvtpk(r0.z, r0.w); w1.x = cvtpk(r1.x, r1.y); w1.y = cvtpk(r1.z, r1.w);
                        *(u32x2*)p = w0; *(u32x2*)(p + 16) = w1;
                    } else if (u.pn == 2) {
                        if (bj == 0) {
                            const f32x4 r0 = v0 * cs - v1 * sn, r1 = v0 * sn + v1 * cs;
                            const int col = wc * 32 + 4 * fq;
                            bf16* p = Kb + (size_t)row * 128 + col;
                            u32x2 w0, w1; w0.x = cvtpk(r0.x, r0.y); w0.y = cvtpk(r0.z, r0.w); w1.x = cvtpk(r1.x, r1.y); w1.y = cvtpk(r1.z, r1.w);
                            *(u32x2*)p = w0; *(u32x2*)(p + 16) = w1;
                            if (!latent) { *(f32x4*)(ok + (size_t)row * 128 + col) = v0; *(f32x4*)(ok + (size_t)row * 128 + col + 16) = v1; }
                        } else {
                            const int col = wc * 32 + 4 * fq;
                            bf16* p = VT + (size_t)col * NTOK + row;
                            p[0 * NTOK] = (bf16)f2bf(v0.x); p[1 * NTOK] = (bf16)f2bf(v0.y); p[2 * NTOK] = (bf16)f2bf(v0.z); p[3 * NTOK] = (bf16)f2bf(v0.w);
                            p[16 * NTOK] = (bf16)f2bf(v1.x); p[17 * NTOK] = (bf16)f2bf(v1.y); p[18 * NTOK] = (bf16)f2bf(v1.z); p[19 * NTOK] = (bf16)f2bf(v1.w);
                            if (!latent) { *(f32x4*)(ov + (size_t)row * 128 + col) = v0; *(f32x4*)(ov + (size_t)row * 128 + col + 16) = v1; }
                        }
                    } else {
                        bf16* p = U + (size_t)row * 512 + (u.pn - 3) * 256 + bj * 128 + wc * 32 + 4 * fq;
                        u32x2 w0, w1; w0.x = cvtpk(v0.x, v0.y); w0.y = cvtpk(v0.z, v0.w); w1.x = cvtpk(v1.x, v1.y); w1.y = cvtpk(v1.z, v1.w);
                        *(u32x2*)p = w0; *(u32x2*)(p + 16) = w1;
                    }
                }
            }
    }
};

template <bool IN_PLACE> struct EpiResid {
    static constexpr bool PERM = false, AFTER_DRAIN = false, HAS_BEGIN = false; static constexpr int MID = (!IN_PLACE && MK_FUSE5) ? 8 : 0;
    const float *xp, *xs, *MOD; float* out; int gate_off; LAS float* rs = nullptr;
    __device__ __forceinline__ void mid(f32x4 (&acc)[2][2][4][2], int wr, int fr) const {
#pragma unroll
        for (int ai = 0; ai < 2; ++ai)
#pragma unroll
            for (int m = 0; m < 4; ++m) { const float sc = rs[ai * 128 + wr * 64 + m * 16 + fr];
#pragma unroll
                for (int bj = 0; bj < 2; ++bj)
#pragma unroll
                    for (int n = 0; n < 2; ++n) acc[ai][bj][m][n] = acc[ai][bj][m][n] * sc; }
    }
    __device__ __forceinline__ void operator()(const f32x4 (&acc)[2][2][4][2], const pg8::Unit& u, int wr, int wc, int fr, int fq) const {
        const int rowt = u.pm * 256 + (u.hm > 0 ? 128 : 0); const int cls = row_cls(rowt); const int nai = u.hm >= 0 ? 1 : 2;
        const float* gp = MOD + cls * 6144 + gate_off + u.pn * 256 + wc * 32 + 4 * fq;
        f32x4 gt[2][2];
#pragma unroll
        for (int bj = 0; bj < 2; ++bj)
#pragma unroll
            for (int n = 0; n < 2; ++n) gt[bj][n] = *(const f32x4*)(gp + bj * 128 + n * 16);
#pragma unroll
        for (int ai = 0; ai < 2; ++ai) { if (ai >= nai) break;
#pragma unroll
            for (int m = 0; m < 4; ++m) {
                const int row = rowt + ai * 128 + wr * 64 + m * 16 + fr;
                const size_t off = (size_t)row * DM + u.pn * 256 + wc * 32 + 4 * fq;
                const float* xin = IN_PLACE ? out + off : (row < NCTX ? xp + off : xs + (off - (size_t)NCTX * DM));
#pragma unroll
                for (int bj = 0; bj < 2; ++bj)
#pragma unroll
                    for (int n = 0; n < 2; ++n) { const f32x4 xv = *(const f32x4*)(xin + bj * 128 + n * 16); *(f32x4*)(out + off + bj * 128 + n * 16) = xv + gt[bj][n] * acc[ai][bj][m][n]; }
            } }
    }
};

__device__ __forceinline__ float fmac_shr1(float acc, float x, float w) { asm("v_fmac_f32_dpp %0, %1, %2 row_shr:1 row_mask:0xf bank_mask:0xf bound_ctrl:1" : "+v"(acc) : "v"(x), "v"(w)); return acc; }
__device__ __forceinline__ float fmac_shl1(float acc, float x, float w) { asm("v_fmac_f32_dpp %0, %1, %2 row_shl:1 row_mask:0xf bank_mask:0xf bound_ctrl:1" : "+v"(acc) : "v"(x), "v"(w)); return acc; }
__device__ __forceinline__ float fmac_ror1(float acc, float x, float w) { asm("v_fmac_f32_dpp %0, %1, %2 row_ror:1 row_mask:0xf bank_mask:0xf" : "+v"(acc) : "v"(x), "v"(w)); return acc; }
__device__ __forceinline__ float fmac_ror15(float acc, float x, float w) { asm("v_fmac_f32_dpp %0, %1, %2 row_ror:15 row_mask:0xf bank_mask:0xf" : "+v"(acc) : "v"(x), "v"(w)); return acc; }
struct EpiUpConv {
    static constexpr bool PERM = false, AFTER_DRAIN = false, HAS_BEGIN = MK_EPI3 != 0; static constexpr int MID = 0;
    bf16* ACT; float* SB; const float *cw, *cb; LAS float* xb; LAS float* cwl;
    __device__ __forceinline__ void begin(const pg8::Unit& u) const {
#pragma unroll
        for (int i = 0; i < 2; ++i) { const int idx = (int)threadIdx.x + 512 * i, prm = idx >> 8, col = idx & 255, bj = col >> 7, wi = bj * DFF + u.pn * 128 + (col & 127);
            const float v = prm < 3 ? cw[prm * UPW + wi] : cb[wi];
            cwl[idx] = v * (bj ? -0.6931471805599453f : -1.4426950408889634f); }
    }
    __device__ __forceinline__ void operator()(const f32x4 (&acc)[2][2][4][2], const pg8::Unit& u, int wr, int wc, int fr, int fq) const {
        const int lane = fr + 16 * fq;
        LAS float* xl = xb + (2 * wr) * 256 + wc * 32 + 4 * fq;
#pragma unroll
        for (int ai = 0; ai < 2; ++ai) { const int sp = 2 * ai + wr;
#pragma unroll
            for (int bj = 0; bj < 2; ++bj)
#pragma unroll
                for (int n = 0; n < 2; ++n) { const int tc = bj * 128 + wc * 32 + n * 16 + 4 * fq;
                    if (fr == 0) *(LAS f32x4*)(xl + (1 + 4 * ai) * 256 + bj * 128 + n * 16) = acc[ai][bj][0][n];
                    if (fr == 15) *(LAS f32x4*)(xl + (2 + 4 * ai) * 256 + bj * 128 + n * 16) = acc[ai][bj][3][n];
                    float* sb = SB + ((size_t)(u.pm * 22 + u.pn) * 4) * 256 + tc;
                    if (sp == 0 && fr < 2) *(f32x4*)(sb + fr * 256) = acc[ai][bj][0][n];
                    if (sp == 3 && fr >= 14) *(f32x4*)(sb + (fr - 12) * 256) = acc[ai][bj][3][n];
                } }
        asm volatile("s_waitcnt lgkmcnt(0)" ::: "memory"); __builtin_amdgcn_s_barrier(); asm volatile("" ::: "memory");
        const int f0 = u.pn * 128 + wc * 32 + 4 * fq;
#if MK_EPI3
#pragma unroll
        for (int ai = 0; ai < 2; ++ai) { const int sp = 2 * ai + wr;
#pragma unroll
            for (int n = 0; n < 2; ++n) {
                f32x4 sg[4];
#pragma unroll
                for (int bj = 0; bj < 2; ++bj) { const int tc = bj * 128 + wc * 32 + n * 16 + 4 * fq;
                    const f32x4 w0 = *(const LAS f32x4*)(cwl + tc), w1 = *(const LAS f32x4*)(cwl + 256 + tc), w2 = *(const LAS f32x4*)(cwl + 512 + tc), bb = *(const LAS f32x4*)(cwl + 768 + tc);
                    const f32x4 z4 = {0.f, 0.f, 0.f, 0.f};
                    const f32x4 w0e = fr == 0 ? w0 : z4, w2e = fr == 15 ? w2 : z4;
                    f32x4 pv = z4, nv = z4;
                    if (sp > 0) pv = *(const LAS f32x4*)(xl + (4 * ai) * 256 + bj * 128 + n * 16);
                    if (sp < 3) nv = *(const LAS f32x4*)(xl + (3 + 4 * ai) * 256 + bj * 128 + n * 16);
#pragma unroll
                    for (int m = 0; m < 4; ++m) { f32x4 rs;
#pragma unroll
                        for (int j = 0; j < 4; ++j) { const float cur = acc[ai][bj][m][n][j];
                            float r = fmaf(w1[j], cur, bb[j]);
                            r = fmac_shr1(r, cur, w0[j]); r = fmac_shl1(r, cur, w2[j]);
                            r = (m > 0) ? fmac_ror1(r, acc[ai][bj][m > 0 ? m - 1 : 0][n][j], w0e[j]) : fmaf(pv[j], w0e[j], r);
                            r = (m < 3) ? fmac_ror15(r, acc[ai][bj][m < 3 ? m + 1 : 3][n][j], w2e[j]) : fmaf(nv[j], w2e[j], r);
                            rs[j] = r; }
                        if (bj == 0) {
#pragma unroll
                            for (int j = 0; j < 4; ++j) sg[m][j] = rs[j] * __builtin_amdgcn_rcpf(1.f + __builtin_amdgcn_exp2f(rs[j]));
                        } else { const int row = u.pm * 256 + ai * 128 + wr * 64 + m * 16 + fr;
                            u32x2 w; w.x = cvtpk(sg[m].x * rs.x, sg[m].y * rs.y); w.y = cvtpk(sg[m].z * rs.z, sg[m].w * rs.w);
                            const bool edge = (u.pm >= 16) && ((sp == 0 && m == 0 && fr == 0) || (sp == 3 && m == 3 && fr == 15));
                            if (!edge) *(u32x2*)(ACT + (size_t)row * DFF + f0 + n * 16) = w; }
                    }
                    __builtin_amdgcn_sched_barrier(0);
                }
            } }
#else
#pragma unroll
        for (int ai = 0; ai < 2; ++ai) { const int sp = 2 * ai + wr;
#pragma unroll
            for (int n = 0; n < 2; ++n) {
                f32x4 sg[4];
#pragma unroll
                for (int bj = 0; bj < 2; ++bj) { const int tc = bj * 128 + wc * 32 + n * 16 + 4 * fq; const int wi = bj * DFF + f0 + n * 16;
                    const f32x4 w0 = *(const f32x4*)(cw + wi), w1 = *(const f32x4*)(cw + UPW + wi), w2 = *(const f32x4*)(cw + 2 * UPW + wi), bb = *(const f32x4*)(cb + wi);
                    f32x4 pv = {0.f, 0.f, 0.f, 0.f}, nv = {0.f, 0.f, 0.f, 0.f};
                    if (sp > 0) pv = *(const LAS f32x4*)(xl + (4 * ai) * 256 + bj * 128 + n * 16);
                    if (sp < 3) nv = *(const LAS f32x4*)(xl + (3 + 4 * ai) * 256 + bj * 128 + n * 16);
#pragma unroll
                    for (int m = 0; m < 4; ++m) { const f32x4 cur = acc[ai][bj][m][n]; f32x4 up, dn;
#pragma unroll
                        for (int j = 0; j < 4; ++j) {
                            const int fu = (m > 0) ? __builtin_amdgcn_update_dpp(0, __float_as_int(acc[ai][bj][m > 0 ? m - 1 : 0][n][j]), 0x121, 0xF, 0xF, false) : __float_as_int(pv[j]);
                            up[j] = __int_as_float(__builtin_amdgcn_update_dpp(fu, __float_as_int(cur[j]), 0x111, 0xF, 0xF, false));
                            const int fd = (m < 3) ? __builtin_amdgcn_update_dpp(0, __float_as_int(acc[ai][bj][m < 3 ? m + 1 : 3][n][j]), 0x12F, 0xF, 0xF, false) : __float_as_int(nv[j]);
                            dn[j] = __int_as_float(__builtin_amdgcn_update_dpp(fd, __float_as_int(cur[j]), 0x101, 0xF, 0xF, false));
                        }
                        const f32x4 rs = w0 * up + w1 * cur + w2 * dn + bb;
                        if (bj == 0) { sg[m].x = siluf(rs.x); sg[m].y = siluf(rs.y); sg[m].z = siluf(rs.z); sg[m].w = siluf(rs.w); }
                        else { const int row = u.pm * 256 + ai * 128 + wr * 64 + m * 16 + fr;
                            u32x2 w; w.x = cvtpk(sg[m].x * rs.x, sg[m].y * rs.y); w.y = cvtpk(sg[m].z * rs.z, sg[m].w * rs.w);
                            const bool edge = (u.pm >= 16) && ((sp == 0 && m == 0 && fr == 0) || (sp == 3 && m == 3 && fr == 15));
                            if (!edge) *(u32x2*)(ACT + (size_t)row * DFF + f0 + n * 16) = w; }
                    }
                    __builtin_amdgcn_sched_barrier(0);
                }
            } }
#endif
        asm volatile("s_waitcnt lgkmcnt(0)" ::: "memory"); __builtin_amdgcn_s_barrier(); asm volatile("" ::: "memory");
    }
};

struct EpiProbe {
    static constexpr bool PERM = false, AFTER_DRAIN = false, HAS_BEGIN = false; static constexpr int MID = 0;
    float* sink;
    __device__ __forceinline__ void operator()(const f32x4 (&acc)[2][2][4][2], const pg8::Unit& u, int wr, int wc, int fr, int fq) const {
        f32x4 t = {0.f, 0.f, 0.f, 0.f};
#pragma unroll
        for (int ai = 0; ai < 2; ++ai)
#pragma unroll
            for (int bj = 0; bj < 2; ++bj)
#pragma unroll
                for (int m = 0; m < 4; ++m)
#pragma unroll
                    for (int n = 0; n < 2; ++n) t += acc[ai][bj][m][n];
        if (t.x + t.y + t.z + t.w == 123456.789f) sink[threadIdx.x] = t.x;
    }
};

__device__ __forceinline__ void p_conv_fix(Frame& F, const Args& a) {
    const float* SB = (const float*)(a.ws + WS_SB); bf16* ACT = (bf16*)(a.ws + WS_ACT);
    const int npm = F.xo < 80 ? (80 - F.xo + F.nx - 1) / F.nx : 0;
    const int gtl = (F.rank * NWAVES + F.wave) * 64 + F.lane, NGTL = F.nloc * NWAVES * 64;
    for (int lt = 0; lt < npm; ++lt) { const int pm = F.xo + F.nx * lt; if (pm < 16) continue;
        const int tl = (pm - 16) & 15;
        for (int i = gtl; i < 2 * DFF; i += NGTL) {
            const int which = i / DFF, f = i - which * DFF;
            const int pn = f >> 7, cc = f & 127;
            float gv[2];
#pragma unroll
            for (int bj = 0; bj < 2; ++bj) {
                const int tc = bj * 128 + cc, wi = bj * DFF + f;
                const float* s0 = SB + ((size_t)(pm * 22 + pn) * 4) * 256 + tc;
                float upv, cur, dnv;
                if (which == 0) { cur = s0[0]; dnv = s0[256]; upv = tl > 0 ? SB[((size_t)((pm - 1) * 22 + pn) * 4 + 3) * 256 + tc] : 0.f; }
                else { cur = s0[3 * 256]; upv = s0[2 * 256]; dnv = tl < 15 ? SB[((size_t)((pm + 1) * 22 + pn) * 4) * 256 + tc] : 0.f; }
                gv[bj] = a.conv_w[wi] * upv + a.conv_w[UPW + wi] * cur + a.conv_w[2 * UPW + wi] * dnv + a.conv_b[wi];
            }
            const int row = pm * 256 + (which ? 255 : 0);
            ACT[(size_t)row * DFF + f] = (bf16)f2bf(siluf(gv[0]) * gv[1]);
        }
    }
}

__device__ __forceinline__ int crow(int r, int hh) { return (r & 3) + 8 * (r >> 2) + 4 * hh; }
struct AttnSt { float m, l; f32x16 o0, o1; };
constexpr int AK_STRIDE = 272, AV_STRIDE = 136, AK_BYTES = 64 * AK_STRIDE, AV_BYTES = 128 * AV_STRIDE;
constexpr int ATT_KOFF = 0, ATT_VOFF = 2 * AK_BYTES, ATT_SQOFF = 2 * AK_BYTES + 2 * AV_BYTES;
template <bool MASK> __device__ __forceinline__ void attn_tile(AttnSt& st, const bf16x8 (&qf)[4], const LAS unsigned char* kt, const LAS unsigned char* vt, int ts, int Lk, int qi, int ql, int hh) {
    f32x16 p0 = {}, p1 = {};
    const LAS unsigned char* kp0 = kt + ql * AK_STRIDE + 16 * hh; const LAS unsigned char* kp1 = kp0 + 32 * AK_STRIDE;
    const LAS unsigned char* vp = vt + ql * AV_STRIDE + 8 * hh;
    bf16x8 ka[4], kb[4];
    u32x2 va[2][2][2][2];
#pragma unroll
    for (int s = 0; s < 4; ++s) { ka[s] = *(const LAS bf16x8*)(kp0 + 32 * s); kb[s] = *(const LAS bf16x8*)(kp1 + 32 * s); }
#pragma unroll
    for (int s = 0; s < 2; ++s)
#pragma unroll
        for (int db = 0; db < 2; ++db) { const LAS unsigned char* a0 = vp + db * 32 * AV_STRIDE + 32 * s; va[0][s][db][0] = *(const LAS u32x2*)a0; va[0][s][db][1] = *(const LAS u32x2*)(a0 + 16); }
    __builtin_amdgcn_sched_barrier(0);
#pragma unroll
    for (int s = 0; s < 4; ++s) { p0 = __builtin_amdgcn_mfma_f32_32x32x16_bf16(ka[s], qf[s], p0, 0, 0, 0); p1 = __builtin_amdgcn_mfma_f32_32x32x16_bf16(kb[s], qf[s], p1, 0, 0, 0); }
    __builtin_amdgcn_sched_barrier(0);
#pragma unroll
    for (int s = 0; s < 2; ++s)
#pragma unroll
        for (int db = 0; db < 2; ++db) { const LAS unsigned char* a0 = vp + db * 32 * AV_STRIDE + 64 + 32 * s; va[1][s][db][0] = *(const LAS u32x2*)a0; va[1][s][db][1] = *(const LAS u32x2*)(a0 + 16); }
    __builtin_amdgcn_sched_barrier(0);
    if (MASK) {
#pragma unroll
        for (int r = 0; r < 16; ++r) { const int key0 = ts + crow(r, hh), key1 = key0 + 32;
            const bool v0 = key0 >= 0 && key0 < Lk && key0 - qi >= -128 && key0 - qi <= 128;
            const bool v1 = key1 >= 0 && key1 < Lk && key1 - qi >= -128 && key1 - qi <= 128;
            p0[r] = v0 ? p0[r] : -1e30f; p1[r] = v1 ? p1[r] : -1e30f; }
    }
    float mt = p0[0];
#pragma unroll
    for (int r = 1; r < 16; ++r) mt = fmaxf(mt, p0[r]);
#pragma unroll
    for (int r = 0; r < 16; ++r) mt = fmaxf(mt, p1[r]);
    mt = max_x32(mt);
    const float mn = fmaxf(st.m, mt);
    if (__builtin_amdgcn_ballot_w64(mn != st.m) != 0ull) {
        const float alpha = __builtin_amdgcn_exp2f(st.m - mn);
        st.l *= alpha; st.o0 = st.o0 * alpha; st.o1 = st.o1 * alpha; st.m = mn;
    }
    float ls = 0.f;
#pragma unroll
    for (int r = 0; r < 16; ++r) { p0[r] = __builtin_amdgcn_exp2f(p0[r] - mn); p1[r] = __builtin_amdgcn_exp2f(p1[r] - mn); ls += p0[r] + p1[r]; }
    st.l += ls;
#pragma unroll
    for (int kb2 = 0; kb2 < 2; ++kb2)
#pragma unroll
        for (int s = 0; s < 2; ++s) {
            const f32x16& p = kb2 ? p1 : p0;
            v4u bw; bw.x = cvtpk(p[8 * s + 0], p[8 * s + 1]); bw.y = cvtpk(p[8 * s + 2], p[8 * s + 3]); bw.z = cvtpk(p[8 * s + 4], p[8 * s + 5]); bw.w = cvtpk(p[8 * s + 6], p[8 * s + 7]);
            const bf16x8 bfrag = __builtin_bit_cast(bf16x8, bw);
#pragma unroll
            for (int db = 0; db < 2; ++db) {
                v4u aw; aw.x = va[kb2][s][db][0].x; aw.y = va[kb2][s][db][0].y; aw.z = va[kb2][s][db][1].x; aw.w = va[kb2][s][db][1].y;
                const bf16x8 afrag = __builtin_bit_cast(bf16x8, aw);
                if (db == 0) st.o0 = __builtin_amdgcn_mfma_f32_32x32x16_bf16(afrag, bfrag, st.o0, 0, 0, 0);
                else st.o1 = __builtin_amdgcn_mfma_f32_32x32x16_bf16(afrag, bfrag, st.o1, 0, 0, 0);
            }
        }
}

struct AttnStage { v4u k[2], v[2]; };
__device__ __forceinline__ void attn_stage_load(AttnStage& sg, const bf16* kbase, const bf16* vtbase, int vds, int ts, int Lk, int tid) {
#pragma unroll
    for (int i = 0; i < 2; ++i) { const int idx = tid + 512 * i;
        int key = ts + (idx >> 4); key = key < 0 ? 0 : (key >= Lk ? Lk - 1 : key);
        sg.k[i] = *(const v4u*)(kbase + (size_t)key * 128 + (idx & 15) * 8);
        int tok = ts + (idx & 7) * 8; tok = tok < 0 ? 0 : (tok >= Lk ? Lk - 8 : tok);
        sg.v[i] = *(const v4u*)(vtbase + (size_t)(idx >> 3) * vds + tok); }
}
__device__ __forceinline__ void attn_stage_store(const AttnStage& sg, LAS unsigned char* kt, LAS unsigned char* vt, int tid) {
#pragma unroll
    for (int i = 0; i < 2; ++i) { const int idx = tid + 512 * i;
        *(LAS v4u*)(kt + (idx >> 4) * AK_STRIDE + (idx & 15) * 16) = sg.k[i];
        LAS unsigned char* vd = vt + (idx >> 3) * AV_STRIDE + (idx & 7) * 16;
        u32x2 a, b; a.x = sg.v[i].x; a.y = sg.v[i].y; b.x = sg.v[i].z; b.y = sg.v[i].w;
        *(LAS u32x2*)vd = a; *(LAS u32x2*)(vd + 8) = b; }
}

template <int MODE> __device__ __forceinline__ void attn_unit(Frame& F, const Args& a, int is_lat, int b, int qb) {
    const int h = F.wave, kvh = h >> 2, ql = F.lane & 31, hh = F.lane >> 5;
    const int L = is_lat ? 4096 : 256, row0 = is_lat ? NCTX + b * 4096 : b * 256, q0 = qb * 32;
    const bf16* Q = (const bf16*)(a.ws + WS_Q); const bf16* Kb = (const bf16*)(a.ws + WS_K); const bf16* VT = (const bf16*)(a.ws + WS_VT);
    const bf16* kloc = Kb + (size_t)row0 * 128;
    const bf16* vloc = VT + row0;
    const bf16* kctx = (const bf16*)(a.ws + WS_CTXK) + (size_t)b * 512 * 128;
    const bf16* vctx = (const bf16*)(a.ws + WS_CTXVT) + (size_t)b * 128 * 512;
    const int nt = is_lat ? 13 : 4;
    LAS unsigned char* lds = F.lds;
    AttnStage sg;
#define ATT_LOAD(t) do { if (is_lat && (t) >= 5) attn_stage_load(sg, kctx, vctx, 512, 64 * ((t) - 5), 512, F.tid); \
                         else attn_stage_load(sg, kloc, vloc, NTOK, is_lat ? q0 - 128 + 64 * (t) : 64 * (t), L, F.tid); } while (0)
    ATT_LOAD(0);
    bf16x8 qf[4];
    { const bf16* qp = Q + (size_t)(row0 + q0 + ql) * 512 + h * 64 + 8 * hh;
#pragma unroll
      for (int s = 0; s < 4; ++s) qf[s] = *(const bf16x8*)(qp + 16 * s); }
    AttnSt st; st.m = a.sink[h] * LOG2E; st.l = hh == 0 ? 1.f : 0.f; st.o0 = f32x16{}; st.o1 = f32x16{};
    const int qi = q0 + ql;
    attn_stage_store(sg, lds + ATT_KOFF, lds + ATT_VOFF, F.tid);
    __syncthreads();
    for (int t = 0; t < nt; ++t) {
        const int cur = t & 1;
        if (t + 1 < nt) ATT_LOAD(t + 1);
        const LAS unsigned char* kt = lds + ATT_KOFF + cur * AK_BYTES + kvh * 128;
        const LAS unsigned char* vt = lds + ATT_VOFF + cur * AV_BYTES + kvh * 64 * AV_STRIDE;
        const int tsl = q0 - 128 + 64 * t;
        if (is_lat && t < 5 && (t == 0 || t == 4 || tsl < 0 || tsl + 64 > L)) attn_tile<true>(st, qf, kt, vt, tsl, L, qi, ql, hh);
        else attn_tile<false>(st, qf, kt, vt, 0, 0, qi, ql, hh);
        if (t + 1 < nt) attn_stage_store(sg, lds + ATT_KOFF + (cur ^ 1) * AK_BYTES, lds + ATT_VOFF + (cur ^ 1) * AV_BYTES, F.tid);
        __syncthreads();
    }
#undef ATT_LOAD
    const float lt = sum_x32(st.l), inv = 1.f / lt;
    float ss = 0.f;
#pragma unroll
    for (int r = 0; r < 16; ++r) { st.o0[r] *= inv; st.o1[r] *= inv; ss += st.o0[r] * st.o0[r] + st.o1[r] * st.o1[r]; }
    ss = sum_x32(ss);
    LAS float* sq = (LAS float*)(lds + ATT_SQOFF);
    if (hh == 0) sq[h * 32 + ql] = ss;
    __syncthreads();
    float tot = 0.f;
#pragma unroll
    for (int w = 0; w < 8; ++w) tot += sq[w * 32 + ql];
    const float rstd = rsqrtf(tot * (1.f / 512.f) + RMS_EPS);
    bf16* AO = (bf16*)(a.ws + (MODE ? (size_t)210 * MiB : WS_AO)) + (size_t)(row0 + q0 + ql) * DM + (MK_FUSE5 ? 512 : 0) + h * 64;
#pragma unroll
    for (int db = 0; db < 2; ++db)
#pragma unroll
        for (int rq = 0; rq < 4; ++rq) { const int d0 = 32 * db + 8 * rq + 4 * hh; const f32x4 g = *(const f32x4*)(a.g_attn + h * 64 + d0);
            const f32x16& o = db ? st.o1 : st.o0;
            u32x2 w; w.x = cvtpk(o[4 * rq] * rstd * g.x, o[4 * rq + 1] * rstd * g.y); w.y = cvtpk(o[4 * rq + 2] * rstd * g.z, o[4 * rq + 3] * rstd * g.w);
            *(u32x2*)(AO + d0) = w; }
    __syncthreads();
}

struct Cx { float r, i; };
__device__ __forceinline__ Cx cmul(Cx a, Cx b) { return Cx{a.r * b.r - a.i * b.i, a.r * b.i + a.i * b.r}; }
__device__ __forceinline__ Cx cfma(Cx a, Cx b, Cx c) { return Cx{a.r * b.r - a.i * b.i + c.r, a.r * b.i + a.i * b.r + c.i}; }
__device__ __forceinline__ Cx cstep(Cx a, Cx h, float br, float bi) {
#if MK_NOASM
    return cfma(a, h, Cx{br, bi});
#endif
    float t0, t1, r, i;
    asm("v_fma_f32 %0, %1, %2, %3" : "=v"(t0) : "v"(a.r), "v"(h.r), "v"(br));
    asm("v_fma_f32 %0, %1, %2, %3" : "=v"(t1) : "v"(a.r), "v"(h.i), "v"(bi));
    asm("v_fma_f32 %0, -%1, %2, %3" : "=v"(r) : "v"(a.i), "v"(h.i), "v"(t0));
    asm("v_fma_f32 %0, %1, %2, %3" : "=v"(i) : "v"(a.i), "v"(h.r), "v"(t1));
    return Cx{r, i};
}
#define MFMA_PAD2(x, y) asm volatile("s_nop 15\n\ts_nop 7" : "+v"(x), "+v"(y))
__device__ __forceinline__ float shx32(float v) {
    const auto rr = __builtin_amdgcn_permlane32_swap(__float_as_uint(v), __float_as_uint(v), false, false);
    return __uint_as_float(((int)__builtin_amdgcn_mbcnt_hi(~0u, __builtin_amdgcn_mbcnt_lo(~0u, 0u)) >= 32) ? rr[0] : rr[1]);
}
__device__ __forceinline__ Cx cshx(Cx a) { return Cx{shx32(a.r), shx32(a.i)}; }
struct SegInfo { int L, row0, nseg, segbase, sl, isl, seq; };
__device__ __forceinline__ SegInfo seg_info(int sg) {
    SegInfo s;
    if (sg < 32) { s.isl = 0; s.seq = sg >> 1; s.L = 256; s.row0 = s.seq * 256; s.nseg = 2; s.segbase = s.seq * 2; s.sl = sg & 1; }
    else { const int t = sg - 32; s.isl = 1; s.seq = t >> 5; s.L = 4096; s.row0 = NCTX + s.seq * 4096; s.nseg = 32; s.segbase = 32 + s.seq * 32; s.sl = t & 31; }
    return s;
}
__device__ __forceinline__ int bu_pos(int i) { return 64 * ((i >> 2) & 1) + (i & 3) + 4 * (i >> 3); }

__device__ __forceinline__ void ssm_pass_a(Frame& F, const Args& a, int unit) {
    const int sg = unit >> 6, gi = unit & 63, dr = gi >> 5, g = gi & 31;
    const SegInfo si = seg_info(sg);
    const int c = F.lane & 31, hh = F.lane >> 5;
    const unsigned char* cb = a.ws + WS_SSMC + (size_t)gi * 16384;
    const bf16* BBm = (const bf16*)cb; const float* AP = (const float*)(cb + 8192);
    bf16x8 bb[4];
#pragma unroll
    for (int q = 0; q < 4; ++q) bb[q] = *(const bf16x8*)(BBm + (q * 32 + c) * 16 + 8 * hh);
    const Cx a0{AP[c], AP[64 + c]}, a1{AP[32 + c], AP[96 + c]}, a64_0{AP[128 + c], AP[192 + c]}, a64_1{AP[160 + c], AP[224 + c]};
    const bf16* U = (const bf16*)(a.ws + WS_U);
    Cx S0{0.f, 0.f}, S1{0.f, 0.f};
    const int pi = bu_pos(c);
    bf16x8 uav[4];
#pragma unroll
    for (int blk = 0; blk < 4; ++blk) { const int p = si.sl * 128 + blk * 16 + pi; const int tok = dr ? si.L - 1 - p : p; uav[blk] = *(const bf16x8*)(U + (size_t)(si.row0 + tok) * 512 + g * 16 + 8 * hh); }
#pragma unroll
    for (int blk = 0; blk < 4; ++blk) {
        const f32x16 z = {};
        f32x16 b0 = __builtin_amdgcn_mfma_f32_32x32x16_bf16(uav[blk], bb[0], z, 0, 0, 0), b1 = __builtin_amdgcn_mfma_f32_32x32x16_bf16(uav[blk], bb[1], z, 0, 0, 0);
        f32x16 b2 = __builtin_amdgcn_mfma_f32_32x32x16_bf16(uav[blk], bb[2], z, 0, 0, 0), b3 = __builtin_amdgcn_mfma_f32_32x32x16_bf16(uav[blk], bb[3], z, 0, 0, 0);
        MFMA_PAD2(b0, b1); MFMA_PAD2(b2, b3);
#pragma unroll
        for (int r = 0; r < 16; ++r) { S0 = cstep(a0, S0, b0[r], b1[r]); S1 = cstep(a1, S1, b2[r], b3[r]); }
    }
    const Cx x0 = cshx(S0), x1 = cshx(S1);
    const Cx f0 = hh ? x0 : S0, s0 = hh ? S0 : x0, f1 = hh ? x1 : S1, s1 = hh ? S1 : x1;
    const Cx e0 = cfma(a64_0, f0, s0), e1 = cfma(a64_1, f1, s1);
    float* E = (float*)(a.ws + WS_ESEG) + ((size_t)sg * 64 + gi) * 256;
    if (hh == 0) { E[c] = e0.r; E[32 + c] = e0.i; E[64 + c] = e1.r; E[96 + c] = e1.i; E[128 + c] = f0.r; E[160 + c] = f0.i; E[192 + c] = f1.r; E[224 + c] = f1.i; }
}

__device__ __forceinline__ void pass_a_queue(Frame& F, const Args& a, unsigned* cntU, int qoff = 0) {
    const int npm = F.xo < 80 ? (80 - F.xo + F.nx - 1) / F.nx : 0;
    tiles_wait(F, cntU, 0, npm, 4u);
    unsigned* head = (unsigned*)F.ctl + CW_PAQ + qoff + 64 * F.xo;
    volatile LAS unsigned* slot = F.MISC + 40;
    unsigned kn = 0;
    if (F.tid == 0) kn = __hip_atomic_fetch_add(head, 8u, __ATOMIC_RELAXED, __HIP_MEMORY_SCOPE_AGENT);
    for (int it = 0; ; ++it) {
        if (F.tid == 0) { slot[it & 1] = kn; kn = __hip_atomic_fetch_add(head, 8u, __ATOMIC_RELAXED, __HIP_MEMORY_SCOPE_AGENT); }
        __syncthreads();
        const unsigned k0 = slot[it & 1];
        if (k0 >= (unsigned)(npm * 128)) break;
        const unsigned k = k0 + (unsigned)F.wave;
        if (k >= (unsigned)(npm * 128)) continue;
        const int pm = F.xo + F.nx * (int)(k >> 7), tsg = 2 * pm + (int)((k >> 6) & 1), gi = (int)(k & 63);
        const SegInfo si = seg_info(tsg);
        const int sg = (gi >> 5) ? si.segbase + (si.nseg - 1 - si.sl) : tsg;
        ssm_pass_a(F, a, sg * 64 + gi);
    }
}

constexpr int PFB = 8;
template <int MODE> __device__ __forceinline__ void ssm_pass_b(Frame& F, const Args& a, int unit) {
    const int tsg = unit >> 5, g = unit & 31;
    const SegInfo si = seg_info(tsg);
    const int c = F.lane & 31, hh = F.lane >> 5, t16 = F.lane & 15, kq = F.lane >> 4;
    const bf16* U = (const bf16*)(a.ws + WS_U);
    LAS unsigned char* Hl = F.lds + F.wave * 8704;
    f32x4 acc[4][2];
#pragma unroll
    for (int i = 0; i < 4; ++i) { acc[i][0] = f32x4{0.f, 0.f, 0.f, 0.f}; acc[i][1] = f32x4{0.f, 0.f, 0.f, 0.f}; }
    const unsigned char* gb = a.ws + WS_SSMG + (size_t)g * 1024;
    const bf16x4 wg = *(const bf16x4*)((const bf16*)gb + t16 * 16 + 4 * kq);
    const f32x4 dv = *(const f32x4*)((const float*)(gb + 512) + 4 * kq);
    bf16* SS = (bf16*)(a.ws + (MODE ? WS_XN : (MK_FUSE5 ? WS_AO : WS_SS)));
    constexpr int SSW = MK_FUSE5 ? DM : 512;
    float* PS = (float*)(a.ws + (MODE ? (size_t)250 * MiB : WS_PS));
    const int pi = bu_pos(c);
#pragma unroll
    for (int dr = 0; dr < 2; ++dr) {
        const int gi = dr * 32 + g;
        const unsigned char* cb = a.ws + WS_SSMC + (size_t)gi * 16384;
        const bf16* BBm = (const bf16*)cb; const bf16* CM = (const bf16*)(cb + 4096); const float* AP = (const float*)(cb + 8192);
        bf16x8 bb[4], cm[4];
#pragma unroll
        for (int q = 0; q < 4; ++q) { bb[q] = *(const bf16x8*)(BBm + (q * 32 + c) * 16 + 8 * hh); cm[q] = *(const bf16x8*)(CM + t16 * 128 + 32 * q + 8 * kq); }
        const Cx a0{AP[c], AP[64 + c]}, a1{AP[32 + c], AP[96 + c]}, a64_0{AP[128 + c], AP[192 + c]}, a64_1{AP[160 + c], AP[224 + c]}, a128_0{AP[256 + c], AP[320 + c]}, a128_1{AP[288 + c], AP[352 + c]};
        const int psl = dr ? si.nseg - 1 - si.sl : si.sl;
        bf16x8 uav[4];
#pragma unroll
        for (int blk = 0; blk < 4; ++blk) { const int p = psl * 128 + blk * 16 + pi; const int tok = dr ? si.L - 1 - p : p; uav[blk] = *(const bf16x8*)(U + (size_t)(si.row0 + tok) * 512 + g * 16 + 8 * hh); }
        const float* E0 = (const float*)(a.ws + WS_ESEG) + ((size_t)si.segbase * 64 + gi) * 256;
        const Cx ef0{E0[(size_t)psl * 16384 + 128 + c], E0[(size_t)psl * 16384 + 160 + c]}, ef1{E0[(size_t)psl * 16384 + 192 + c], E0[(size_t)psl * 16384 + 224 + c]};
        Cx S0{0.f, 0.f}, S1{0.f, 0.f};
        if (si.isl) { const float* hr = a.st_re + (size_t)si.seq * 4096 + gi * 64; const float* hi_ = a.st_im + (size_t)si.seq * 4096 + gi * 64; S0 = Cx{hr[c], hi_[c]}; S1 = Cx{hr[32 + c], hi_[32 + c]}; }
        for (int ps0 = 0; ps0 < psl; ps0 += PFB) {
            float e[PFB][4];
#pragma unroll
            for (int j = 0; j < PFB; ++j) { const int ps = (ps0 + j < psl) ? ps0 + j : psl - 1; const float* E = E0 + (size_t)ps * 16384;
                e[j][0] = E[c]; e[j][1] = E[32 + c]; e[j][2] = E[64 + c]; e[j][3] = E[96 + c]; }
#pragma unroll
            for (int j = 0; j < PFB; ++j) { const bool ok = ps0 + j < psl; const Cx n0 = cfma(a128_0, S0, Cx{e[j][0], e[j][1]}), n1 = cfma(a128_1, S1, Cx{e[j][2], e[j][3]});
                S0 = ok ? n0 : S0; S1 = ok ? n1 : S1; }
        }
        u32x2 uwv[4][2];
        if (dr == 1) {
#pragma unroll
            for (int tb = 0; tb < 4; ++tb)
#pragma unroll
                for (int th = 0; th < 2; ++th) uwv[tb][th] = *(const u32x2*)(U + (size_t)(si.row0 + si.sl * 128 + 64 * th + 16 * tb + t16) * 512 + g * 16 + 4 * kq);
        }
        if (hh) { S0 = cfma(a64_0, S0, ef0); S1 = cfma(a64_1, S1, ef1); }
        if (MODE == 5) { if (dr == 1) { u32x2 ow; ow.x = __float_as_uint(S0.r + S1.i) ^ uwv[0][0].x; ow.y = __float_as_uint(S0.i + S1.r) ^ uwv[3][1].y ^ (unsigned)bb[0][0] ^ (unsigned)cm[3][1] ^ (unsigned)uav[2][3]; *(u32x2*)(SS + (size_t)(si.row0 + si.sl * 128 + t16) * 512 + g * 16 + 4 * kq) = ow; } continue; }
#pragma unroll
        for (int blk = 0; blk < 4; ++blk) {
            const int tb = dr ? 3 - blk : blk;
            const bf16x8 ua = uav[blk];
#pragma unroll
            for (int nh = 0; nh < 2; ++nh) {
                const f32x16 z = {};
                f32x16 br = __builtin_amdgcn_mfma_f32_32x32x16_bf16(ua, bb[2 * nh], z, 0, 0, 0), bi = __builtin_amdgcn_mfma_f32_32x32x16_bf16(ua, bb[2 * nh + 1], z, 0, 0, 0);
                MFMA_PAD2(br, bi);
                const Cx an = nh ? a1 : a0; Cx h = nh ? S1 : S0;
#pragma unroll
                for (int r = 0; r < 16; ++r) { if (MODE == 2) h = Cx{br[r], bi[r]}; else h = cstep(an, h, br[r], bi[r]); const int pl = 16 * hh + r; const int tl = dr ? 31 - pl : pl;
                    if (MODE != 3) *(LAS unsigned*)(Hl + tl * 272 + 8 * c + 4 * nh) = cvtpk(h.r, h.i); }
                if (nh) S1 = h; else S0 = h;
            }
            asm volatile("s_waitcnt lgkmcnt(0)" ::: "memory");
#pragma unroll
            for (int th = 0; th < 2; ++th)
#pragma unroll
                for (int ks = 0; ks < 4; ++ks) { if (MODE == 3) { acc[tb][th].x += S0.r; continue; } const bf16x8 hf = *(const LAS bf16x8*)(Hl + (16 * th + t16) * 272 + (32 * ks + 8 * kq) * 2);
                    acc[tb][th] = __builtin_amdgcn_mfma_f32_16x16x32_bf16(cm[ks], hf, acc[tb][th], 0, 0, 0); }
            asm volatile("s_waitcnt lgkmcnt(0)" ::: "memory");
            if (dr == 1) {
#pragma unroll
                for (int th = 0; th < 2; ++th) {
                    const int tokn = si.sl * 128 + 64 * th + 16 * tb + t16;
                    const size_t ro = (size_t)(si.row0 + tokn) * SSW + g * 16 + 4 * kq;
                    const u32x2 uw = uwv[tb][th];
                    f32x4 y = acc[tb][th];
                    y.x += bf2f((unsigned short)(uw.x & 0xffffu)) * dv.x; y.y += bf2f((unsigned short)(uw.x >> 16)) * dv.y;
                    y.z += bf2f((unsigned short)(uw.y & 0xffffu)) * dv.z; y.w += bf2f((unsigned short)(uw.y >> 16)) * dv.w;
                    f32x4 x; x.x = gelu_tanh(y.x); x.y = gelu_tanh(y.y); x.z = gelu_tanh(y.z); x.w = gelu_tanh(y.w);
                    u32x2 xb; xb.x = cvtpk(x.x, x.y); xb.y = cvtpk(x.z, x.w);
                    const f32x4 zz = __builtin_amdgcn_mfma_f32_16x16x16bf16_1k(wg, __builtin_bit_cast(bf16x4, xb), f32x4{0.f, 0.f, 0.f, 0.f}, 0, 0, 0);
                    const float o0 = x.x * fast_sigmoid(zz.x), o1 = x.y * fast_sigmoid(zz.y), o2 = x.z * fast_sigmoid(zz.z), o3 = x.w * fast_sigmoid(zz.w);
                    u32x2 ow; ow.x = cvtpk(o0, o1); ow.y = cvtpk(o2, o3);
                    *(u32x2*)(SS + ro) = ow;
                    if (MK_FUSE5) { const float q = sum_x32(sum_x16((o0 * o0 + o1 * o1) + (o2 * o2 + o3 * o3))); if (kq == 0) PS[(size_t)(si.row0 + tokn) * 32 + g] = q; }
                }
            }
        }
        if (MODE == 0 && !si.isl && psl == si.nseg - 1 && hh == 1) {
            float* ore = a.out + 22020096 + (size_t)(si.seq * 2 + dr) * 2048 + g * 64; float* oim = ore + 65536;
            ore[c] = S0.r; ore[32 + c] = S1.r; oim[c] = S0.i; oim[32 + c] = S1.i;
        }
    }
}

__device__ __forceinline__ void p_ssm_norm(Frame& F, const Args& a) {
    const int gw = (int)blockIdx.x * NWAVES + F.wave, NGW = F.G * NWAVES;
    const bf16* SS = (const bf16*)(a.ws + WS_SS); bf16* AO = (bf16*)(a.ws + WS_AO);
    for (int row = gw; row < NTOK; row += NGW) {
        const v4u w = *(const v4u*)(SS + (size_t)row * 512 + 8 * F.lane);
        float v[8]; v[0] = bf2f(w.x & 0xffff); v[1] = bf2f(w.x >> 16); v[2] = bf2f(w.y & 0xffff); v[3] = bf2f(w.y >> 16); v[4] = bf2f(w.z & 0xffff); v[5] = bf2f(w.z >> 16); v[6] = bf2f(w.w & 0xffff); v[7] = bf2f(w.w >> 16);
        float s = 0.f;
#pragma unroll
        for (int j = 0; j < 8; ++j) s += v[j] * v[j];
        const float rstd = rsqrtf(wave_sum(s) * (1.f / 512.f) + RMS_EPS);
        const f32x4 g0 = *(const f32x4*)(a.g_ssm + 8 * F.lane), g1 = *(const f32x4*)(a.g_ssm + 8 * F.lane + 4);
        v4u o; o.x = cvtpk(v[0] * rstd * g0.x, v[1] * rstd * g0.y); o.y = cvtpk(v[2] * rstd * g0.z, v[3] * rstd * g0.w); o.z = cvtpk(v[4] * rstd * g1.x, v[5] * rstd * g1.y); o.w = cvtpk(v[6] * rstd * g1.z, v[7] * rstd * g1.w);
        *(v4u*)(AO + (size_t)row * DM + 512 + 8 * F.lane) = o;
    }
}

__device__ __forceinline__ void p_final_norm(Frame& F, const Args& a, unsigned* cnt = nullptr) {
    ROWS_AFFINE_BEGIN(F, row, cnt, 4, MK_HALVES) {
        int rw[2] = {row, row2};
        f32x4 v[2][4]; float s[2] = {0.f, 0.f};
#pragma unroll
        for (int q = 0; q < 2; ++q)
#pragma unroll
            for (int j = 0; j < 4; ++j) v[q][j] = *(const f32x4*)(a.out + (size_t)rw[q] * DM + 4 * F.lane + 256 * j);
#pragma unroll
        for (int q = 0; q < 2; ++q)
#pragma unroll
            for (int j = 0; j < 4; ++j) s[q] += (v[q][j].x * v[q][j].x + v[q][j].y * v[q][j].y) + (v[q][j].z * v[q][j].z + v[q][j].w * v[q][j].w);
#pragma unroll
        for (int q = 0; q < 2; ++q) { if (q == 1 && !has2) break;
            const float rstd = rsqrtf(wave_sum(s[q]) * (1.f / DM) + RMS_EPS);
#pragma unroll
            for (int j = 0; j < 4; ++j) { const f32x4 g = *(const f32x4*)(a.g_final + 4 * F.lane + 256 * j); *(f32x4*)(a.out + (size_t)rw[q] * DM + 4 * F.lane + 256 * j) = v[q][j] * rstd * g; } }
    } ROWS_AFFINE_END
}

__device__ __forceinline__ void l2_thrash(Frame& F, const Args& a, int salt) {
    const f32x4* p = (const f32x4*)(a.x_sample) + ((size_t)((blockIdx.x + 37 * salt) & 255) * 16384) + F.tid;
    f32x4 s = {0.f, 0.f, 0.f, 0.f};
#pragma unroll 8
    for (int i = 0; i < 32; ++i) s += p[(size_t)i * 512];
    if (s.x + s.y + s.z + s.w == 123456.789f) a.out[22151167] = s.x;
}
#ifndef MK_NRUN
#define MK_NRUN N_PHASES
#endif
#ifndef MK_DIAG_TWICE
#define MK_DIAG_TWICE 0
#endif
#if MK_DIAG_TWICE
__global__ void diag_compare(const unsigned* a, const unsigned* b, int n, unsigned* cnt) {
    unsigned c = 0;
    for (int i = blockIdx.x * blockDim.x + threadIdx.x; i < n; i += gridDim.x * blockDim.x) c += (a[i] != b[i]) ? 1u : 0u;
    if (c) atomicAdd(cnt, c);
}
__global__ void diag_apply(float* y, int n, const unsigned* cnt) {
    if (!cnt[0]) return;
    const unsigned c = cnt[0]; const int b = c < 16u ? 0 : c < 256u ? 1 : c < 4096u ? 2 : c < 65536u ? 3 : c < 1048576u ? 4 : 5;
    const float s = 1.f + 1.5f + 0.25f * (float)b;
    for (int i = blockIdx.x * blockDim.x + threadIdx.x; i < n; i += gridDim.x * blockDim.x) y[i] *= s;
}
#endif
#ifndef MK_THRASH
#define MK_THRASH 1
#endif
#ifndef MK_OVERLAP
#define MK_OVERLAP 3
#endif
#define OV6 ((MK_OVERLAP) & 1)
#define OV10 (((MK_OVERLAP) >> 1) & 1)
#ifndef MK_SHADOW
#define MK_SHADOW 0
#endif
#ifndef MK_REPEAT_MASK
#define MK_REPEAT_MASK 0x0
#endif
#ifndef MK_CUTMASK
#define MK_CUTMASK 0
#endif
#define MK_PER_PHASE (MK_CUTMASK == 0x7FF)
constexpr int N_PHASES = 12;
__global__ void __launch_bounds__(NWAVES * 64, 2) __attribute__((target("no-packed-fp32-ops"))) mega_fwd(Args args) {
    extern __shared__ __attribute__((aligned(16))) unsigned char lds[];
    Frame F;
    F.lds = (LAS unsigned char*)lds;
    F.MISC = (volatile LAS unsigned*)(F.lds + MISC_OFF);
    F.tid = threadIdx.x; F.lane = F.tid & 63; F.wave = __builtin_amdgcn_readfirstlane(F.tid >> 6);
    F.G = gridDim.x;
    F.ctl = (gu32*)(args.ws + WS_CTL);
    for (int u = F.tid; u < (LDS_BYTES - LDSCTL_OFF) / 4; u += NWAVES * 64) ((LAS unsigned*)(F.lds + LDSCTL_OFF))[u] = 0u;
    __syncthreads();
    XcdBarrier bar = xcd_barrier_post((unsigned*)(F.ctl + CW_BAR) + args.li * XCD_BAR_WORDS, F.MISC + 8);
    if (F.tid == 0) {
        unsigned* rk = (unsigned*)(F.ctl + CW_RANK) + args.li * 1024;
        const unsigned rank = xb_add(&rk[64 * bar.x], 1u);
        unsigned nloc, nx; xcd_barrier_complete(bar.bar, bar.x, nloc, nx); bar.st[0] = nloc; bar.st[1] = nx;
        unsigned ord = 0;
        for (unsigned j = 0; j < 16; ++j) { const unsigned c = xb_ld(&bar.bar[XB_XCNT(j)]); if (j < bar.x && c > 0u) ++ord; }
        F.MISC[10] = ord; F.MISC[11] = rank; F.MISC[12] = nloc; F.MISC[13] = nx;
    }
    __syncthreads();
    F.xo = (int)F.MISC[10]; F.rank = (int)F.MISC[11]; F.nloc = (int)F.MISC[12]; F.nx = (int)F.MISC[13];
    F.xo = __builtin_amdgcn_readfirstlane(F.xo); F.rank = __builtin_amdgcn_readfirstlane(F.rank); F.nloc = __builtin_amdgcn_readfirstlane(F.nloc); F.nx = __builtin_amdgcn_readfirstlane(F.nx);
#define GRID_BAR() do { if (!MK_PER_PHASE) xcd_barrier(bar); } while (0)
    const int lo = args.ph_lo, hi = args.ph_hi;
#ifndef MK_PHASE_MASK
#define MK_PHASE_MASK 0xFFF
#endif
#define IN(k) (((MK_PHASE_MASK >> (k)) & 1) && lo <= (k) && (k) < hi)
#define SEAM(k) do { if (IN(k) && IN((k) + 1)) GRID_BAR(); } while (0)
#define SEAM_L(k) do { if (IN(k) && IN((k) + 1)) { if (MK_LIGHT) { if (!MK_PER_PHASE) xcd_barrier_local(bar); } else GRID_BAR(); } } while (0)
    unsigned char* ws = args.ws;

    if (IN(0)) for (int rep_ = 0; rep_ < (((MK_REPEAT_MASK >> 0) & 1) ? 2 : 1); ++rep_) { if (rep_) GRID_BAR(); p0_setup(F, args); } SEAM(0);
    if (IN(1)) for (int rep_ = 0; rep_ < (((MK_REPEAT_MASK >> 1) & 1) ? 2 : 1); ++rep_) { if (rep_) GRID_BAR(); p_modulate(F, args, 0); } SEAM_L(1);
    if (IN(2)) for (int rep_ = 0; rep_ < (((MK_REPEAT_MASK >> 2) & 1) ? 2 : 1); ++rep_) { if (rep_) GRID_BAR();
        pg8::Gemm g{(const pg8::bf16_t*)(ws + WS_XN), (const pg8::bf16_t*)(ws + WS_WIN), NTOK, INW, DM}; XcdOrder S; S.init(NTOK, INW, F);
        unsigned* cntU = (unsigned*)F.ctl + CW_TCNT + 16384 + rep_ * 8192;
        if (MK_PAQ) { S.rot = 3; S.cpn = 3; S.cnt = cntU; }
        EpiInProj E{(bf16*)(ws + WS_Q), (bf16*)(ws + WS_K), (bf16*)(ws + WS_VT), (bf16*)(ws + WS_U), args.out + 20971520, args.out + 21495808, (const float*)(ws + WS_ROPE), (const float*)(ws + WS_ROPE) + 1024};
        pg8::gemm_phase<EpiInProj, XcdOrder, true, true>(F.lds + RING_OFF, g, S, E);
        if (MK_PAQ) pass_a_queue(F, args, cntU, rep_ * 2048);
        if (MK_TQ) { __syncthreads(); transpose_queue(F, args); }
#if MK_SHADOW == 30
        GRID_BAR(); pass_a_queue(F, args, cntU, 4096);
#endif
    } SEAM(2);
    if (IN(3)) for (int rep_ = 0; rep_ < (((MK_REPEAT_MASK >> 3) & 1) ? 2 : 1); ++rep_) { if (rep_) GRID_BAR();
        const int gw = (int)blockIdx.x * NWAVES + F.wave, NGW = F.G * NWAVES;
        if (!MK_PAQ) for (int u = gw; u < NSEG * 64; u += NGW) ssm_pass_a(F, args, u);
        __syncthreads();
#if MK_ATTX
        {
            const int cs = (512 + F.nx - 1) / F.nx, u0 = F.xo * cs, u1 = u0 + cs < 512 ? u0 + cs : 512;
            for (int u = u0 + F.rank; u < u1; u += F.nloc) attn_unit<0>(F, args, 1, u >> 7, u & 127);
            if (!MK_CTXB) for (int u = 512 + blockIdx.x; u < 640; u += F.G) attn_unit<0>(F, args, 0, (u - 512) >> 3, (u - 512) & 7);
        }
#else
        for (int u = blockIdx.x; u < (MK_CTXB ? 512 : 640); u += F.G) { if (u < 512) attn_unit<0>(F, args, 1, u >> 7, u & 127); else attn_unit<0>(F, args, 0, (u - 512) >> 3, (u - 512) & 7); }
#endif
#if MK_SHADOW == 10
        GRID_BAR();
        for (int u = blockIdx.x; u < 640; u += F.G) { if (u < 512) attn_unit<1>(F, args, 1, u >> 7, u & 127); else attn_unit<1>(F, args, 0, (u - 512) >> 3, (u - 512) & 7); }
#endif
    } SEAM(3);
    if (IN(4)) for (int rep_ = 0; rep_ < (((MK_REPEAT_MASK >> 4) & 1) ? 2 : 1); ++rep_) { if (rep_) GRID_BAR();
        int gw = (int)blockIdx.x * NWAVES + F.wave; const int NGW = F.G * NWAVES;
        if (MK_CTXB) { for (int u = 512 + blockIdx.x; u < 640; u += F.G) attn_unit<0>(F, args, 0, (u - 512) >> 3, (u - 512) & 7);
            gw = (gw + NGW / 2) % NGW; }
        for (int u = gw; u < NSEG * 32; u += NGW) ssm_pass_b<0>(F, args, u);
#if MK_SHADOW > 0 && MK_SHADOW < 10
        GRID_BAR();
        for (int u = gw; u < NSEG * 32; u += NGW) ssm_pass_b<MK_SHADOW>(F, args, u);
#endif
    } SEAM(4);
    if (!MK_FUSE5) { if (IN(5)) for (int rep_ = 0; rep_ < (((MK_REPEAT_MASK >> 5) & 1) ? 2 : 1); ++rep_) { if (rep_) GRID_BAR(); p_ssm_norm(F, args); } SEAM(5); }
    if (IN(6)) for (int rep_ = 0; rep_ < (((MK_REPEAT_MASK >> 6) & 1) ? 2 : 1); ++rep_) { if (rep_) GRID_BAR();
        unsigned* cnt = OV6 ? (unsigned*)F.ctl + CW_TCNT : nullptr;
        pg8::Gemm g{(const pg8::bf16_t*)(ws + WS_AO), (const pg8::bf16_t*)(ws + WS_WOUT), NTOK, DM, DM}; XcdOrder S; S.init(NTOK, DM, F, OV6, cnt);
        EpiResid<false> E{args.x_prompt, args.x_sample, (const float*)(ws + WS_MOD), args.out, 2048};
        if (MK_FUSE5) { S.ps = (const float*)(ws + WS_PS); S.rs = (LAS float*)(F.lds + XBUF_OFF); E.rs = S.rs; }
        pg8::gemm_phase<EpiResid<false>, XcdOrder, true, true>(F.lds + RING_OFF, g, S, E);
        if (OV6) p_modulate(F, args, 1, cnt);
    } if (OV6) SEAM_L(6); else SEAM(6);
    if (IN(7)) for (int rep_ = 0; rep_ < (((MK_REPEAT_MASK >> 7) & 1) ? 2 : 1); ++rep_) { if (rep_) GRID_BAR(); if (!OV6) p_modulate(F, args, 1); } if (!OV6) SEAM(7);
    if (IN(8)) for (int rep_ = 0; rep_ < (((MK_REPEAT_MASK >> 8) & 1) ? 2 : 1); ++rep_) { if (rep_) GRID_BAR();
        pg8::Gemm g{(const pg8::bf16_t*)(ws + WS_XN), (const pg8::bf16_t*)(ws + WS_WUP), NTOK, UPW, DM}; XcdOrder S; S.init(NTOK, UPW, F);
        EpiUpConv E{(bf16*)(ws + WS_ACT), (float*)(ws + WS_SB), args.conv_w, args.conv_b, (LAS float*)(F.lds + XBUF_OFF), (LAS float*)(F.lds + CWL_OFF)};
        pg8::gemm_phase<EpiUpConv, XcdOrder, true, true>(F.lds + RING_OFF, g, S, E);
#if MK_SHADOW == 20 || MK_SHADOW == 21
        GRID_BAR();
        { pg8::Gemm g2{(const pg8::bf16_t*)(ws + WS_XN), (const pg8::bf16_t*)(ws + WS_WUP), NTOK, UPW, DM}; XcdOrder S2; S2.init(NTOK, UPW, F);
          if (MK_SHADOW == 20) { EpiProbe E2{(float*)(ws + 250 * MiB)}; pg8::gemm_phase<EpiProbe, XcdOrder, true, true>(F.lds + RING_OFF, g2, S2, E2); }
          else { EpiUpConv E2{(bf16*)(ws + WS_ACT), (float*)(ws + WS_SB), args.conv_w, args.conv_b, (LAS float*)(F.lds + XBUF_OFF), (LAS float*)(F.lds + CWL_OFF)}; pg8::gemm_phase<EpiUpConv, XcdOrder, true, true>(F.lds + RING_OFF, g2, S2, E2); } }
#endif
    } SEAM(8);
    if (IN(9)) for (int rep_ = 0; rep_ < (((MK_REPEAT_MASK >> 9) & 1) ? 2 : 1); ++rep_) { if (rep_) GRID_BAR(); p_conv_fix(F, args); } SEAM_L(9);
    if (IN(10)) for (int rep_ = 0; rep_ < (((MK_REPEAT_MASK >> 10) & 1) ? 2 : 1); ++rep_) { if (rep_) GRID_BAR();
        unsigned* cnt = OV10 ? (unsigned*)F.ctl + CW_TCNT + 8192 : nullptr;
        pg8::Gemm g{(const pg8::bf16_t*)(ws + WS_ACT), (const pg8::bf16_t*)(ws + WS_WDN), NTOK, DM, DFF}; XcdOrderT<(OV10 && MK_HALVES)> S; S.init(NTOK, DM, F, OV10, cnt);
        EpiResid<true> E{nullptr, nullptr, (const float*)(ws + WS_MOD), args.out, 5120};
        pg8::gemm_phase<EpiResid<true>, XcdOrderT<(OV10 && MK_HALVES)>, true, true>(F.lds + RING_OFF, g, S, E);
        if (OV10) p_final_norm(F, args, cnt);
    } if (!OV10) SEAM(10);
    if (IN(11)) for (int rep_ = 0; rep_ < (((MK_REPEAT_MASK >> 11) & 1) ? 2 : 1); ++rep_) { if (rep_) GRID_BAR(); if (!OV10) p_final_norm(F, args); }
#undef IN
#undef SEAM
#undef SEAM_L
}

extern "C" void kernel_launch(void* const* d_in, const int* in_sizes, int n_in, void* d_out, int out_size, void* d_ws, size_t ws_size, hipStream_t stream) {
    static int grid = 0;
    if (grid == 0) {
        if (n_in != 31 || ws_size < WS_END) { fprintf(stderr, "kernel_launch: unexpected inputs (n_in %d, ws %zu)\n", n_in, ws_size); grid = -1; return; }
        int dev = 0, cus = 0, per_cu = 0;
        if (hipGetDevice(&dev) != hipSuccess || hipDeviceGetAttribute(&cus, hipDeviceAttributeMultiprocessorCount, dev) != hipSuccess) { grid = -1; return; }
        if (hipFuncSetAttribute((const void*)mega_fwd, hipFuncAttributeMaxDynamicSharedMemorySize, LDS_BYTES) != hipSuccess) { fprintf(stderr, "kernel_launch: hipFuncSetAttribute failed\n"); grid = -1; return; }
        if (hipOccupancyMaxActiveBlocksPerMultiprocessor(&per_cu, (const void*)mega_fwd, NWAVES * 64, LDS_BYTES) != hipSuccess || per_cu < 1) fprintf(stderr, "kernel_launch: occupancy query reports %d\n", per_cu);
        (void)hipGetLastError();
        grid = cus;
    }
    if (grid < 0) return;
    Args a{};
    const float** ap = (const float**)&a;
    for (int i = 0; i < 31; ++i) ap[i] = (const float*)d_in[i];
    a.out = (float*)d_out; a.ws = (unsigned char*)d_ws;
#if MK_DIAG_TWICE
    static const int rsrc[6] = {128 * 4, 1 * 4, 1 * 4, 1 * 4, 1 * 4, 1 * 4}, rsz[6] = {20 * 4, 1, 1, 1, 1, 1};
    for (int rep = 0; rep < 2; ++rep) {
#endif
#if MK_NANPOISON
    (void)hipMemsetAsync((char*)d_ws + 1 * MiB, 0xFF, (size_t)253 * MiB, stream);
    (void)hipMemsetAsync(d_out, 0xFF, (size_t)out_size * 4, stream);
#endif
    if (hipMemsetAsync((char*)d_ws + WS_CTL, 0, CTL_ZERO_BYTES, stream) != hipSuccess) return;
    { int lo = 0; a.li = 0;
    for (int p = 0; p < MK_NRUN; ++p) if (p == MK_NRUN - 1 || ((MK_CUTMASK >> p) & 1)) { a.ph_lo = lo; a.ph_hi = p + 1; hipLaunchKernelGGL(mega_fwd, dim3(grid), dim3(NWAVES * 64), LDS_BYTES, stream, a); lo = p + 1; ++a.li; } }
#if MK_DIAG_TWICE
    if (rep == 0) { (void)hipMemsetAsync((char*)d_ws + 211 * MiB, 0, 256, stream); size_t dst = 212 * MiB;
        for (int r = 0; r < 6; ++r) { (void)hipMemcpyAsync((char*)d_ws + dst, (char*)d_ws + (size_t)rsrc[r] * (MiB / 4), (size_t)rsz[r] * (MiB / 4), hipMemcpyDeviceToDevice, stream); dst += (size_t)rsz[r] * (MiB / 4); } }
    }
    { size_t dst = 212 * MiB;
      for (int r = 0; r < 6; ++r) { hipLaunchKernelGGL(diag_compare, dim3(1024), dim3(256), 0, stream, (const unsigned*)((char*)d_ws + (size_t)rsrc[r] * (MiB / 4)), (const unsigned*)((char*)d_ws + dst), (int)((size_t)rsz[r] * (MiB / 4) / 4), (unsigned*)((char*)d_ws + 211 * MiB) + r); dst += (size_t)rsz[r] * (MiB / 4); } }
    if (MK_NRUN < N_PHASES) { (void)hipMemsetAsync(d_out, 0, (size_t)20971520 * 4, stream); if (MK_NRUN < 5) (void)hipMemsetAsync((float*)d_out + 22020096, 0, (size_t)131072 * 4, stream); }
    hipLaunchKernelGGL(diag_apply, dim3(1024), dim3(256), 0, stream, (float*)d_out + 20971520, 524288, (const unsigned*)((char*)d_ws + 211 * MiB));
#endif
}
```
